# Optimizing an MI355X kernel written in HIP

```python
import jax, jax.numpy as jnp
from jax import lax
import numpy as np

D_MODEL = 1024
BATCH = 8
SEQ = 4096
DEPTH = 4

CHUNK = 64
Q_BLOCK = 128
EPS = 1e-6
NEG_INF = -1e30

MLA_HEADS = 8
MLA_NOPE = 64
MLA_ROPE = 32
MLA_QK = MLA_NOPE + MLA_ROPE
MLA_V = 64
Q_LORA = 256
KV_LORA = 128
ROPE_BASE = 10000.0
MLA_WIDTH = MLA_HEADS * MLA_V

CA_HEADS = 8
CA_HEAD_DIM = 64
CA_WIDTH = CA_HEADS * CA_HEAD_DIM
LEFT_CHUNKS = 8
BAND_CHUNKS = LEFT_CHUNKS + 1
BAND = BAND_CHUNKS * CHUNK
REL_CLIP = 128
N_REL = 2 * REL_CLIP + 1

D_MIX = MLA_WIDTH + CA_WIDTH
OFF_CQ = 0
OFF_CKV = OFF_CQ + Q_LORA
OFF_KR = OFF_CKV + KV_LORA
OFF_CA = OFF_KR + MLA_ROPE
IN_COLS = OFF_CA + 3 * CA_WIDTH

D_FF = 2816
CONV_W = 3

kernel_name = "hybrid_mla_chunkrel_convglu"


def rmsnorm(x, g):
    xf = x.astype(jnp.float32)
    y = xf * lax.rsqrt(jnp.mean(xf * xf, axis=-1, keepdims=True) + EPS)
    return (y * g.astype(jnp.float32)).astype(x.dtype)


def rope_tables(positions):
    inv = ROPE_BASE ** (-jnp.arange(0, MLA_ROPE, 2, dtype=jnp.float32) / MLA_ROPE)
    ang = positions.astype(jnp.float32)[..., None] * inv
    return jnp.cos(ang), jnp.sin(ang)


def apply_rope(t, cos, sin):
    t1, t2 = jnp.split(t.astype(jnp.float32), 2, axis=-1)
    c = cos[:, :, None, :]
    s = sin[:, :, None, :]
    return jnp.concatenate([t1 * c - t2 * s, t1 * s + t2 * c], axis=-1).astype(t.dtype)


def rope_tail(t, cos, sin):
    return jnp.concatenate([t[..., :MLA_NOPE], apply_rope(t[..., MLA_NOPE:], cos, sin)], axis=-1)


def mla_mixer(c_q, c_kv, k_rope, cos, sin, w_uq, w_ukv, g_qa, g_kva, g_qn, g_kn):
    B, S, _ = c_q.shape
    q = (rmsnorm(c_q, g_qa) @ w_uq).reshape(B, S, MLA_HEADS, MLA_QK)
    kv = (rmsnorm(c_kv, g_kva) @ w_ukv).reshape(B, S, MLA_HEADS, MLA_NOPE + MLA_V)
    k_nope, v = kv[..., :MLA_NOPE], kv[..., MLA_NOPE:]
    k_r = jnp.broadcast_to(k_rope[:, :, None, :], (B, S, MLA_HEADS, MLA_ROPE))
    k = jnp.concatenate([k_nope, k_r], axis=-1)
    q = rope_tail(rmsnorm(q, g_qn), cos, sin)
    k = rope_tail(rmsnorm(k, g_kn), cos, sin)
    scale = MLA_QK ** -0.5
    n_qb = S // Q_BLOCK
    q_blocks = q.reshape(B, n_qb, Q_BLOCK, MLA_HEADS, MLA_QK).transpose(1, 0, 2, 3, 4)
    k_chunk = jnp.arange(S) // CHUNK

    def one_block(args):
        qb, bidx = args
        q_chunk = (bidx * Q_BLOCK + jnp.arange(Q_BLOCK)) // CHUNK
        s = jnp.einsum('bqhd,bkhd->bhqk', qb, k).astype(jnp.float32) * scale
        mask = k_chunk[None, :] <= q_chunk[:, None]
        s = jnp.where(mask[None, None], s, NEG_INF)
        p = jax.nn.softmax(s, axis=-1).astype(v.dtype)
        return jnp.einsum('bhqk,bkhd->bqhd', p, v)

    out = lax.map(one_block, (q_blocks, jnp.arange(n_qb)))
    return out.transpose(1, 0, 2, 3, 4).reshape(B, S, MLA_WIDTH)


def chunk_rel_mixer(qkv, rel_bias, g_qn, g_kn):
    B, S, _ = qkv.shape
    nc = S // CHUNK
    qkv = qkv.reshape(B, S, 3, CA_HEADS, CA_HEAD_DIM)
    q = rmsnorm(qkv[:, :, 0], g_qn)
    k = rmsnorm(qkv[:, :, 1], g_kn)
    v = qkv[:, :, 2]
    qc = q.reshape(B, nc, CHUNK, CA_HEADS, CA_HEAD_DIM)

    def band(t):
        tc = t.reshape(B, nc, CHUNK, CA_HEADS, CA_HEAD_DIM)
        tp = jnp.pad(tc, ((0, 0), (LEFT_CHUNKS, 0), (0, 0), (0, 0), (0, 0)))
        return jnp.concatenate([tp[:, j:j + nc] for j in range(BAND_CHUNKS)], axis=2)

    kb, vb = band(k), band(v)
    scale = CA_HEAD_DIM ** -0.5
    s = jnp.einsum('bcqhd,bckhd->bhcqk', qc, kb).astype(jnp.float32) * scale
    qi = jnp.arange(CHUNK)
    kj = jnp.arange(BAND)
    dist = qi[:, None] + LEFT_CHUNKS * CHUNK - kj[None, :]
    idx = jnp.clip(dist, -REL_CLIP, REL_CLIP) + REL_CLIP
    bias = rel_bias[:, idx].astype(jnp.float32)
    valid = (jnp.arange(nc)[:, None] - LEFT_CHUNKS + kj[None, :] // CHUNK) >= 0
    s = jnp.where(valid[None, None, :, None, :], s + bias[None, :, None], NEG_INF)
    p = jax.nn.softmax(s, axis=-1).astype(vb.dtype)
    o = jnp.einsum('bhcqk,bckhd->bcqhd', p, vb)
    return o.reshape(B, S, CA_WIDTH)


def conv_glu_ffn(h, w_up, conv_w, conv_b, w_down):
    S = h.shape[1]
    u = h @ w_up
    up = jnp.pad(u, ((0, 0), (CONV_W - 1, 0), (0, 0)))
    u = sum(up[:, i:i + S] * conv_w[i] for i in range(CONV_W)) + conv_b
    g, val = u[..., :D_FF], u[..., D_FF:]
    return (jax.nn.silu(g) * val) @ w_down


def setup_inputs(seed: int = 0) -> dict:
    key = jax.random.key(seed)
    ks = jax.random.split(key, 24)
    f32 = jnp.float32

    def nrm(k, shape, scale):
        return jax.random.normal(k, shape, f32) * scale

    def gain(k, shape):
        return 1.0 + 0.02 * jax.random.normal(k, shape, f32)

    x = jax.random.normal(ks[0], (BATCH, SEQ, D_MODEL), f32)
    positions = jnp.broadcast_to(jnp.arange(SEQ, dtype=jnp.int32)[None, :], (BATCH, SEQ))
    return {
        "x": x,
        "positions": positions,
        "g_mix": gain(ks[1], (DEPTH, D_MODEL)),
        "w_in": nrm(ks[2], (DEPTH, D_MODEL, IN_COLS), D_MODEL ** -0.5),
        "w_uq": nrm(ks[3], (DEPTH, Q_LORA, MLA_HEADS * MLA_QK), Q_LORA ** -0.5),
        "w_ukv": nrm(ks[4], (DEPTH, KV_LORA, MLA_HEADS * (MLA_NOPE + MLA_V)), KV_LORA ** -0.5),
        "g_q_lora": gain(ks[5], (DEPTH, Q_LORA)),
        "g_kv_lora": gain(ks[6], (DEPTH, KV_LORA)),
        "g_mla_q": gain(ks[7], (DEPTH, MLA_QK)),
        "g_mla_k": gain(ks[8], (DEPTH, MLA_QK)),
        "g_ca_q": gain(ks[9], (DEPTH, CA_HEAD_DIM)),
        "g_ca_k": gain(ks[10], (DEPTH, CA_HEAD_DIM)),
        "rel_bias": nrm(ks[11], (DEPTH, CA_HEADS, N_REL), 0.2),
        "g_out_mla": gain(ks[12], (DEPTH, MLA_WIDTH)),
        "g_out_ca": gain(ks[13], (DEPTH, CA_WIDTH)),
        "w_out": nrm(ks[14], (DEPTH, D_MIX, D_MODEL), D_MIX ** -0.5),
        "g_ffn": gain(ks[15], (DEPTH, D_MODEL)),
        "w_up": nrm(ks[16], (DEPTH, D_MODEL, 2 * D_FF), D_MODEL ** -0.5),
        "conv_w": nrm(ks[17], (DEPTH, CONV_W, 2 * D_FF), CONV_W ** -0.5),
        "conv_b": nrm(ks[18], (DEPTH, 2 * D_FF), 0.02),
        "w_down": nrm(ks[19], (DEPTH, D_FF, D_MODEL), D_FF ** -0.5),
    }


def reference(x, positions, g_mix, w_in, w_uq, w_ukv, g_q_lora, g_kv_lora, g_mla_q, g_mla_k,
              g_ca_q, g_ca_k, rel_bias, g_out_mla, g_out_ca, w_out, g_ffn, w_up, conv_w,
              conv_b, w_down):
    cos, sin = rope_tables(positions)
    for l in range(DEPTH):
        h = rmsnorm(x, g_mix[l])
        proj = h @ w_in[l]
        c_q = proj[..., OFF_CQ:OFF_CKV]
        c_kv = proj[..., OFF_CKV:OFF_KR]
        k_rope = proj[..., OFF_KR:OFF_CA]
        qkv_b = proj[..., OFF_CA:]
        o_a = mla_mixer(c_q, c_kv, k_rope, cos, sin, w_uq[l], w_ukv[l], g_q_lora[l],
                        g_kv_lora[l], g_mla_q[l], g_mla_k[l])
        o_b = chunk_rel_mixer(qkv_b, rel_bias[l], g_ca_q[l], g_ca_k[l])
        o = jnp.concatenate([rmsnorm(o_a, g_out_mla[l]), rmsnorm(o_b, g_out_ca[l])], axis=-1)
        x = x + o @ w_out[l]
        x = x + conv_glu_ffn(rmsnorm(x, g_ffn[l]), w_up[l], conv_w[l], conv_b[l], w_down[l])
    return x
```

```cpp
#include <hip/hip_runtime.h>
#include <hip/hip_cooperative_groups.h>
#include <cstdio>
#include <cstdint>
namespace cg = cooperative_groups;

#define LAS __attribute__((address_space(3)))
typedef unsigned short bf16_t;
typedef short bf16x8 __attribute__((ext_vector_type(8)));
typedef short s16x4 __attribute__((ext_vector_type(4)));
typedef float f32x4 __attribute__((ext_vector_type(4)));
typedef float f32x16 __attribute__((ext_vector_type(16)));
typedef unsigned u32x4 __attribute__((ext_vector_type(4)));
typedef unsigned u32x2 __attribute__((ext_vector_type(2)));

constexpr int T = 32768, S = 4096, NB = 8, DM = 1024, DEPTH = 4;
constexpr int INC = 1952, PW = 2048;
constexpr int DFF = 2816;
constexpr float EPS = 1e-6f;
constexpr int OFF_CKV = 256, OFF_KR = 384, OFF_CA = 512;
constexpr int NTHR = 512, NWAVES = 8;

constexpr size_t MiB = 1u << 20;
constexpr size_t W_LAYER = (size_t)(4 * MiB + MiB / 2 + MiB / 4 + 2 * MiB + 11 * MiB + 5 * MiB + MiB / 2);
constexpr size_t WO_IN = 0, WO_UQ = 4 * MiB, WO_UKV = WO_UQ + MiB / 2, WO_OUT = WO_UKV + MiB / 4, WO_UP = WO_OUT + 2 * MiB, WO_DOWN = WO_UP + 11 * MiB;
constexpr size_t WS_W = 1 * MiB;
constexpr size_t WS_HB = 96 * MiB;
constexpr size_t WS_PB = 160 * MiB;
constexpr size_t WS_QRAW = 288 * MiB;
constexpr size_t WS_KVRAW = 352 * MiB;
constexpr size_t WS_KM = 416 * MiB;
constexpr size_t WS_ACT = 160 * MiB;
constexpr size_t WS_HB2 = 352 * MiB;
constexpr size_t WS_SSQ = 95 * MiB;
constexpr size_t WS_GSS = 464 * MiB;
constexpr size_t WS_U4 = 336 * MiB;
constexpr size_t WS_RKV = 466 * MiB;
constexpr size_t WS_END = 467 * MiB;
static_assert(WS_W + 4 * W_LAYER <= WS_HB, "weights fit");
static_assert(WS_ACT + (size_t)T * DFF * 2 <= WS_KVRAW, "act overlay");

constexpr int RING_BYTES = 131072;
constexpr int XCH_OFF = RING_BYTES;
constexpr int LDS_BYTES = 147456;
constexpr int MISC_OFF = RING_BYTES + 8192;
constexpr int CW_BAR = 4096;
constexpr size_t CTL_ZERO_BYTES = 65536;

__device__ __forceinline__ unsigned f2bf(float f) { unsigned u = __builtin_bit_cast(unsigned, f); return (u + 0x7fffu + ((u >> 16) & 1u)) >> 16; }
__device__ __forceinline__ unsigned pk2(float lo, float hi) { unsigned r; asm volatile("v_cvt_pk_bf16_f32 %0, %1, %2" : "=v"(r) : "v"(lo), "v"(hi)); return r; }
__device__ __forceinline__ float bflo(unsigned u) { return __builtin_bit_cast(float, u << 16); }
__device__ __forceinline__ float bfhi(unsigned u) { return __builtin_bit_cast(float, u & 0xffff0000u); }

__device__ __forceinline__ float sx(float v, int o, int lane) { return __builtin_bit_cast(float, __builtin_amdgcn_ds_bpermute((lane ^ o) << 2, __builtin_bit_cast(int, v))); }

__device__ __forceinline__ float sum4(const float* p) { const f32x4 v = *(const f32x4*)p; return ((v.x + v.y) + v.z) + v.w; }

namespace pg8 {
constexpr int BM = 256, BK = 64, HALF = 128, HTB = HALF * BK * 2, STAGE_BYTES = 8 * HTB, NXCD = 8, WGM = 8;
__host__ __device__ __forceinline__ int lds_byte(int r, int c) { const int st = (r >> 4) * 2 + (c >> 5), rr = r & 15, cc = c & 31, ob = rr * 64 + cc * 2; return st * 1024 + (ob ^ (((ob >> 9) & 1) << 5)); }
__host__ __device__ __forceinline__ void stage_rc(int b, int& R, int& C) { const int st = b / 1024, sb = b % 1024, swz = sb ^ (((sb >> 9) & 1) << 5); R = (st >> 1) * 16 + swz / 64; C = (st & 1) * 32 + (swz % 64) / 2; }
__host__ __device__ __forceinline__ int perm32(int rho) { const int n = rho >> 4, i = rho & 15; return 8 * (i >> 2) + 4 * n + (i & 3); }

struct Unit { int pm, pn; };
struct Gemm { const bf16_t* A; const bf16_t* Bt; int lda, K, a_step, a_off; };

struct StaticOrder {
    int nM, nN, nwg, G, c;
    __device__ void init(int nM_, int nN_, int G_, int c_) { nM = nM_; nN = nN_; nwg = nM * nN; G = G_; c = c_; }
    __device__ bool next(int i, Unit& u) const {
        const long L = (long)i * G + c; if (L >= nwg) return false;
        int wgid = (int)L; { const int q = nwg / NXCD, r = nwg % NXCD, xcd = wgid % NXCD, off = wgid / NXCD; wgid = (xcd < r ? xcd * (q + 1) : r * (q + 1) + (xcd - r) * q) + off; }
        const int nig = WGM * nN, gid = wgid / nig, fm = gid * WGM, gsz = (nM - fm) < WGM ? (nM - fm) : WGM;
        u.pm = fm + ((wgid % nig) % gsz); u.pn = (wgid % nig) / gsz; return true;
    }
};

template <class Epi>
__device__ __forceinline__ void gemm_phase(LAS unsigned char* lds, const Gemm g, const StaticOrder& S, const Epi& E) {
    int tid = threadIdx.x; asm volatile("" : "+v"(tid));
    const int wid = __builtin_amdgcn_readfirstlane(tid >> 6), lane = tid & 63, wr = wid >> 2, wc = wid & 3, fr = lane & 15, fq = lane >> 4;
    const int K = g.K, nt = K / BK, lda = g.lda;
    unsigned voffA[2], voffB[2];
#pragma unroll
    for (int i = 0; i < 2; ++i) { int R, C; stage_rc(tid * 16 + i * 8192, R, C); const int Rb = (R & ~31) + perm32(R & 31);
        voffA[i] = (unsigned)(R * lda + C) * 2u; voffB[i] = (unsigned)(Rb * K + C) * 2u; }
    const size_t kstep = (size_t)(BK * 2);
    const size_t hstepA = (size_t)HALF * lda * 2, hstepB = (size_t)HALF * K * 2;
    const unsigned ldsw = (unsigned)wid * 1024u;
    const int aoff = lds_byte(wr * 64 + fr, fq * 8), boff = lds_byte(wc * 32 + fr, fq * 8);
#define PG8_SA(b, h) (((b) * 2 + (h)) * HTB)
#define PG8_SB(b, h) ((4 + (b) * 2 + (h)) * HTB)
#define PG8_STAGE(bufoff, gbase, voff) do { _Pragma("unroll") for (int _i = 0; _i < 2; ++_i) \
        __builtin_amdgcn_global_load_lds((const unsigned*)((const char*)(gbase) + (voff)[_i]), (LAS unsigned*)(lds + (bufoff) + ldsw + _i * 8192), 16, 0, 0); } while (0)
#define PG8_LDA(dst, b, h) do { _Pragma("unroll") for (int m = 0; m < 4; ++m) _Pragma("unroll") for (int k = 0; k < 2; ++k) dst[m][k] = *(const LAS bf16x8*)(lds + PG8_SA(b, h) + aoff + m * 2048 + k * 1024); } while (0)
#define PG8_LDB(dst, b, h) do { _Pragma("unroll") for (int n = 0; n < 2; ++n) _Pragma("unroll") for (int k = 0; k < 2; ++k) dst[n][k] = *(const LAS bf16x8*)(lds + PG8_SB(b, h) + boff + n * 2048 + k * 1024); } while (0)
#define PG8_MMA(ai, bj, At, Bt) do { __builtin_amdgcn_s_setprio(1); _Pragma("unroll") for (int m = 0; m < 4; ++m) _Pragma("unroll") for (int n = 0; n < 2; ++n) _Pragma("unroll") for (int k = 0; k < 2; ++k) \
        acc[ai][bj][m][n] = __builtin_amdgcn_mfma_f32_16x16x32_bf16(Bt[n][k], At[m][k], acc[ai][bj][m][n], 0, 0, 0); __builtin_amdgcn_s_setprio(0); } while (0)
#define PG8_WAIT_V(n) asm volatile("s_waitcnt vmcnt(" #n ")" ::: "memory")
#define PG8_WAIT_L(n) asm volatile("s_waitcnt lgkmcnt(" #n ")" ::: "memory")
#define PG8_BAR __builtin_amdgcn_s_barrier()
#define PG8_SCHED __builtin_amdgcn_sched_barrier(0)
    Unit cur, nxt; int ui = 0;
    if (!S.next(0, cur)) return;
    f32x4 acc[2][2][4][2];
#pragma unroll
    for (int a = 0; a < 2; ++a)
#pragma unroll
        for (int b = 0; b < 2; ++b)
#pragma unroll
            for (int m = 0; m < 4; ++m)
#pragma unroll
                for (int n = 0; n < 2; ++n) acc[a][b][m][n] = (f32x4){0.f, 0.f, 0.f, 0.f};
    bf16x8 At[4][2], B0[2][2], B1[2][2];
    const char* cA = (const char*)g.A + ((long)cur.pm * g.a_step + g.a_off) * (long)lda * 2; const char* cB = (const char*)g.Bt + (size_t)cur.pn * 2 * hstepB;
    PG8_STAGE(PG8_SB(0, 0), cB, voffB); PG8_STAGE(PG8_SB(0, 1), cB + hstepB, voffB); PG8_STAGE(PG8_SA(0, 0), cA, voffA); PG8_STAGE(PG8_SA(0, 1), cA + hstepA, voffA);
    if (wr == 1) PG8_BAR;
    PG8_WAIT_V(2); PG8_BAR;
    PG8_STAGE(PG8_SB(1, 0), cB + kstep, voffB); PG8_STAGE(PG8_SA(1, 0), cA + kstep, voffA); PG8_STAGE(PG8_SB(1, 1), cB + hstepB + kstep, voffB);
    PG8_WAIT_V(6); PG8_BAR;
    for (;;) {
        const bool has_next = S.next(ui + 1, nxt);
        const char* nA = has_next ? (const char*)g.A + ((long)nxt.pm * g.a_step + g.a_off) * (long)lda * 2 : cA; const char* nB = has_next ? (const char*)g.Bt + (size_t)nxt.pn * 2 * hstepB : cB;
        for (int t = 0; t < nt; t += 2) {
            if constexpr (Epi::MIDK) { if (t == nt / 2) { int t3 = threadIdx.x; asm volatile("" : "+v"(t3)); const int w3 = __builtin_amdgcn_readfirstlane(t3 >> 6); E.mid(acc, cur, w3 >> 2, t3 & 15); } }
            const bool last = (t == nt - 2);
            const char* a1 = cA + (size_t)(t + 1) * kstep;
            const char* a2 = last ? nA : cA + (size_t)(t + 2) * kstep; const char* b2 = last ? nB : cB + (size_t)(t + 2) * kstep;
            const char* a3 = a2 + kstep; const char* b3 = b2 + kstep;
            PG8_LDB(B0, 0, 0); PG8_LDB(B1, 0, 1); PG8_SCHED; PG8_LDA(At, 0, 0); PG8_STAGE(PG8_SA(1, 1), a1 + hstepA, voffA);
            PG8_WAIT_V(8); PG8_WAIT_L(0); PG8_BAR; PG8_MMA(0, 0, At, B0); PG8_MMA(0, 1, At, B1); PG8_BAR; PG8_SCHED;
            PG8_LDA(At, 0, 1); PG8_STAGE(PG8_SB(0, 0), b2, voffB); PG8_STAGE(PG8_SB(0, 1), b2 + hstepB, voffB); PG8_STAGE(PG8_SA(0, 0), a2, voffA);
            PG8_WAIT_V(8); PG8_WAIT_L(0); PG8_BAR; PG8_MMA(1, 0, At, B0); PG8_MMA(1, 1, At, B1); PG8_BAR; PG8_SCHED;
            PG8_LDB(B0, 1, 0); PG8_LDB(B1, 1, 1); PG8_SCHED; PG8_LDA(At, 1, 0); PG8_STAGE(PG8_SA(0, 1), a2 + hstepA, voffA);
            PG8_WAIT_V(8); PG8_WAIT_L(0); PG8_BAR; PG8_MMA(0, 0, At, B0); PG8_MMA(0, 1, At, B1); PG8_BAR; PG8_SCHED;
            PG8_LDA(At, 1, 1); PG8_STAGE(PG8_SB(1, 0), b3, voffB); PG8_STAGE(PG8_SB(1, 1), b3 + hstepB, voffB); PG8_STAGE(PG8_SA(1, 0), a3, voffA);
            PG8_WAIT_V(8); PG8_WAIT_L(0); PG8_BAR; PG8_MMA(1, 0, At, B0); PG8_MMA(1, 1, At, B1); PG8_BAR; PG8_SCHED;
        }
        if (wr == 0) PG8_BAR;
        { int t2 = threadIdx.x; asm volatile("" : "+v"(t2)); const int w2 = __builtin_amdgcn_readfirstlane(t2 >> 6), l2 = t2 & 63;
          E(acc, cur, w2 >> 2, w2 & 3, l2 & 15, l2 >> 4); }
        if (!has_next) break;
#pragma unroll
        for (int a = 0; a < 2; ++a)
#pragma unroll
            for (int b = 0; b < 2; ++b)
#pragma unroll
                for (int m = 0; m < 4; ++m)
#pragma unroll
                    for (int n = 0; n < 2; ++n) acc[a][b][m][n] = (f32x4){0.f, 0.f, 0.f, 0.f};
        cur = nxt; cA = nA; cB = nB; ++ui;
        if (wr == 1) PG8_BAR;
    }
    PG8_WAIT_V(0);
    PG8_BAR;
#undef PG8_SA
#undef PG8_SB
#undef PG8_STAGE
#undef PG8_LDA
#undef PG8_LDB
#undef PG8_MMA
#undef PG8_WAIT_V
#undef PG8_WAIT_L
#undef PG8_BAR
#undef PG8_SCHED
}

struct EpiProj {
    static constexpr bool MIDK = false;
    bf16_t* O; const float* ssq; const float* gq; const float* gk; float* rkvss;
    __device__ __forceinline__ void operator()(f32x4 (&acc)[2][2][4][2], const Unit& u, int wr, int wc, int fr, int fq) const {
        const int row0 = u.pm * BM + wr * 64 + fr, lane = fq * 16 + fr;
        const bool heads = u.pn >= 2 && u.pn < 6;
        f32x4 g[2][2];
        if (heads) { const float* gp = (u.pn < 4 ? gq : gk) + 8 * fq;
#pragma unroll
            for (int bj = 0; bj < 2; ++bj) { g[bj][0] = *(const f32x4*)(gp + 32 * bj); g[bj][1] = *(const f32x4*)(gp + 32 * bj + 4); } }
#pragma unroll
        for (int ai = 0; ai < 2; ++ai)
#pragma unroll
            for (int m = 0; m < 4; ++m) { const int row = row0 + ai * HALF + m * 16;
                const float rs = 1.f / sqrtf(sum4(ssq + 4 * (size_t)row) * (1.f / DM) + EPS);
                f32x4 v[2][2];
#pragma unroll
                for (int bj = 0; bj < 2; ++bj) { v[bj][0] = acc[ai][bj][m][0] * rs; v[bj][1] = acc[ai][bj][m][1] * rs; }
                if (heads) {
                    float ss = 0.f;
#pragma unroll
                    for (int bj = 0; bj < 2; ++bj)
#pragma unroll
                        for (int n = 0; n < 2; ++n) ss += (v[bj][n][0] * v[bj][n][0] + v[bj][n][1] * v[bj][n][1]) + (v[bj][n][2] * v[bj][n][2] + v[bj][n][3] * v[bj][n][3]);
                    ss += sx(ss, 16, lane); ss += sx(ss, 32, lane);
                    const float rn = 1.f / sqrtf(ss * (1.f / 64.f) + EPS);
                    bf16_t* rowp = O + (size_t)row * PW + u.pn * BM + wc * 64 + 8 * fq;
#pragma unroll
                    for (int bj = 0; bj < 2; ++bj) { const f32x4 a = v[bj][0] * rn * g[bj][0], b = v[bj][1] * rn * g[bj][1];
                        u32x4 w; w.x = pk2(a[0], a[1]); w.y = pk2(a[2], a[3]); w.z = pk2(b[0], b[1]); w.w = pk2(b[2], b[3]);
                        *(u32x4*)(rowp + 32 * bj) = w; }
                } else {
                    if (u.pn == 1) {
                        float ss = (v[0][0][0] * v[0][0][0] + v[0][0][1] * v[0][0][1]) + (v[0][0][2] * v[0][0][2] + v[0][0][3] * v[0][0][3]) + (v[0][1][0] * v[0][1][0] + v[0][1][1] * v[0][1][1]) + (v[0][1][2] * v[0][1][2] + v[0][1][3] * v[0][1][3]);
                        ss += sx(ss, 16, lane); ss += sx(ss, 32, lane);
                        if (fq == 0) rkvss[4 * (size_t)row + wc] = ss; }
                    bf16_t* rowp = O + (size_t)row * PW + u.pn * BM + wc * 32 + 8 * fq;
#pragma unroll
                    for (int bj = 0; bj < 2; ++bj) { u32x4 w; w.x = pk2(v[bj][0][0], v[bj][0][1]); w.y = pk2(v[bj][0][2], v[bj][0][3]); w.z = pk2(v[bj][1][0], v[bj][1][1]); w.w = pk2(v[bj][1][2], v[bj][1][3]);
                        *(u32x4*)(rowp + bj * HALF) = w; }
                }
            }
    }
};
struct EpiKV {
    static constexpr bool MIDK = false;
    bf16_t* KM; bf16_t* VO; const bf16_t* P; const float* rkvss; const float* gk; const int* pos;
    __device__ __forceinline__ void operator()(f32x4 (&acc)[2][2][4][2], const Unit& u, int wr, int wc, int fr, int fq) const {
        const int row0 = u.pm * BM + wr * 64 + fr, lane = fq * 16 + fr, head = 2 * u.pn + (wc & 1);
        if (wc >= 2) {
#pragma unroll
            for (int ai = 0; ai < 2; ++ai)
#pragma unroll
                for (int m = 0; m < 4; ++m) { const int row = row0 + ai * HALF + m * 16;
                    const float rkv = 1.f / sqrtf(sum4(rkvss + 4 * (size_t)row) * (1.f / 128.f) + EPS);
                    bf16_t* rowp = VO + (size_t)row * 1024 + head * 128 + 64 + 8 * fq;
#pragma unroll
                    for (int bj = 0; bj < 2; ++bj) { const f32x4 a = acc[ai][bj][m][0] * rkv, b = acc[ai][bj][m][1] * rkv;
                        u32x4 w; w.x = pk2(a[0], a[1]); w.y = pk2(a[2], a[3]); w.z = pk2(b[0], b[1]); w.w = pk2(b[2], b[3]);
                        *(u32x4*)(rowp + 32 * bj) = w; } }
        } else {
            const float inv0 = (fq & 1) ? 0.01f : 1.f;
#pragma unroll
            for (int ai = 0; ai < 2; ++ai)
#pragma unroll
                for (int m = 0; m < 4; ++m) { const int row = row0 + ai * HALF + m * 16;
                    const float rkv = 1.f / sqrtf(sum4(rkvss + 4 * (size_t)row) * (1.f / 128.f) + EPS);
                    const u32x4 kr = *(const u32x4*)(P + (size_t)row * PW + OFF_KR + 8 * fq);
                    float y[8] = {bflo(kr.x), bfhi(kr.x), bflo(kr.y), bfhi(kr.y), bflo(kr.z), bfhi(kr.z), bflo(kr.w), bfhi(kr.w)};
                    f32x4 v[2][2]; float ss = 0.f;
#pragma unroll
                    for (int bj = 0; bj < 2; ++bj)
#pragma unroll
                        for (int n = 0; n < 2; ++n) { v[bj][n] = acc[ai][bj][m][n] * rkv; ss += (v[bj][n][0] * v[bj][n][0] + v[bj][n][1] * v[bj][n][1]) + (v[bj][n][2] * v[bj][n][2] + v[bj][n][3] * v[bj][n][3]); }
#pragma unroll
                    for (int e = 0; e < 8; ++e) ss += y[e] * y[e];
                    ss += sx(ss, 16, lane); ss += sx(ss, 32, lane);
                    const float rn = 1.f / sqrtf(ss * (1.f / 96.f) + EPS);
                    bf16_t* krow = KM + (size_t)row * 768 + head * 96;
                    f32x4 g[2][2], gr[2];
                    { const float* gp = gk + 8 * fq;
#pragma unroll
                      for (int bj = 0; bj < 2; ++bj) { g[bj][0] = *(const f32x4*)(gp + 32 * bj); g[bj][1] = *(const f32x4*)(gp + 32 * bj + 4); }
                      gr[0] = *(const f32x4*)(gk + 64 + 8 * fq); gr[1] = *(const f32x4*)(gk + 64 + 8 * fq + 4); }
#pragma unroll
                    for (int bj = 0; bj < 2; ++bj) { const f32x4 a = v[bj][0] * rn * g[bj][0], b = v[bj][1] * rn * g[bj][1];
                        u32x4 w; w.x = pk2(a[0], a[1]); w.y = pk2(a[2], a[3]); w.z = pk2(b[0], b[1]); w.w = pk2(b[2], b[3]);
                        *(u32x4*)(krow + 32 * bj + 8 * fq) = w; }
                    const float posf = (float)pos[row];
                    float o[8];
#pragma unroll
                    for (int e = 0; e < 8; ++e) {
                        const float ye = y[e] * rn * gr[e >> 2][e & 3], yp = sx(ye, 32, lane);
                        constexpr float rp_[8] = {1.0f, 0.5623413251903491f, 0.31622776601683794f, 0.1778279410038923f, 0.1f, 0.05623413251903491f, 0.03162277660168379f, 0.01778279410038923f};
                        const float ang = posf * (inv0 * rp_[e]);
                        const double rr = (double)ang - 6.283185307179586 * rint((double)ang * 0.15915494309189535);
                        const float c = __cosf((float)rr), sn = __sinf((float)rr);
                        o[e] = fq < 2 ? ye * c - yp * sn : yp * sn + ye * c; }
                    u32x4 w; w.x = pk2(o[0], o[1]); w.y = pk2(o[2], o[3]); w.z = pk2(o[4], o[5]); w.w = pk2(o[6], o[7]);
                    *(u32x4*)(krow + 64 + 8 * fq) = w; }
        }
    }
};
struct EpiBf16 {
    static constexpr bool MIDK = false;
    bf16_t* O; int ldc; const float* ssq;
    __device__ __forceinline__ void operator()(f32x4 (&acc)[2][2][4][2], const Unit& u, int wr, int wc, int fr, int fq) const {
        const int row0 = u.pm * BM + wr * 64 + fr, col0 = u.pn * BM + wc * 32 + 8 * fq;
#pragma unroll
        for (int ai = 0; ai < 2; ++ai)
#pragma unroll
            for (int m = 0; m < 4; ++m) { const int row = row0 + ai * HALF + m * 16; bf16_t* rowp = O + (size_t)row * ldc + col0;
                const float rs = ssq ? 1.f / sqrtf(sum4(ssq + 4 * (size_t)row) * (1.f / DM) + EPS) : 1.f;
#pragma unroll
                for (int bj = 0; bj < 2; ++bj) { const f32x4 v0 = acc[ai][bj][m][0] * rs, v1 = acc[ai][bj][m][1] * rs;
                    u32x4 w; w.x = pk2(v0[0], v0[1]); w.y = pk2(v0[2], v0[3]); w.z = pk2(v1[0], v1[1]); w.w = pk2(v1[2], v1[3]);
                    *(u32x4*)(rowp + bj * HALF) = w; } }
    }
};
template <bool GN> struct EpiResid {
    static constexpr bool MIDK = GN;
    const bf16_t* xin; float* xout; bf16_t* xb; float* ssq; const float* gss; int f32out; LAS float* xch;
    __device__ __forceinline__ void mid(f32x4 (&acc)[2][2][4][2], const Unit& u, int wr, int fr) const {
#pragma unroll
        for (int ai = 0; ai < 2; ++ai)
#pragma unroll
            for (int m = 0; m < 4; ++m) { const int row = u.pm * BM + ai * HALF + wr * 64 + m * 16 + fr;
                const float* gp = gss + 16 * (size_t)row; const float ra = 1.f / sqrtf((sum4(gp) + sum4(gp + 4)) * (1.f / 512.f) + EPS), rb = 1.f / sqrtf((sum4(gp + 8) + sum4(gp + 12)) * (1.f / 512.f) + EPS), q = ra / rb;
#pragma unroll
                for (int bj = 0; bj < 2; ++bj) { acc[ai][bj][m][0] *= q; acc[ai][bj][m][1] *= q; } }
    }
    __device__ __forceinline__ void operator()(f32x4 (&acc)[2][2][4][2], const Unit& u, int wr, int wc, int fr, int fq) const {
        const int row0 = u.pm * BM + wr * 64 + fr, col0 = u.pn * BM + wc * 32 + 8 * fq, lane = fq * 16 + fr;
#pragma unroll
        for (int ai = 0; ai < 2; ++ai) {
            u32x4 pre[4][2];
#pragma unroll
            for (int m = 0; m < 4; ++m) { const size_t off = (size_t)(row0 + ai * HALF + m * 16) * DM + col0;
#pragma unroll
                for (int bj = 0; bj < 2; ++bj) pre[m][bj] = *(const u32x4*)(xin + off + bj * HALF); }
            asm volatile("" ::: "memory");
#pragma unroll
            for (int m = 0; m < 4; ++m) { const int row = row0 + ai * HALF + m * 16; const size_t off = (size_t)row * DM + col0;
                const float rb = GN ? 1.f / sqrtf((sum4(gss + 16 * (size_t)row + 8) + sum4(gss + 16 * (size_t)row + 12)) * (1.f / 512.f) + EPS) : 1.f;
                float ss = 0.f;
#pragma unroll
                for (int bj = 0; bj < 2; ++bj) {
                    const u32x4 p = pre[m][bj];
                    const f32x4 a = (f32x4){bflo(p.x), bfhi(p.x), bflo(p.y), bfhi(p.y)} + acc[ai][bj][m][0] * rb, b = (f32x4){bflo(p.z), bfhi(p.z), bflo(p.w), bfhi(p.w)} + acc[ai][bj][m][1] * rb;
                    if (f32out) { *(f32x4*)(xout + off + bj * HALF) = a; *(f32x4*)(xout + off + bj * HALF + 4) = b; }
                    else { u32x4 w; w.x = pk2(a[0], a[1]); w.y = pk2(a[2], a[3]); w.z = pk2(b[0], b[1]); w.w = pk2(b[2], b[3]);
                        *(u32x4*)(xb + off + bj * HALF) = w; }
                    ss += (a[0] * a[0] + a[1] * a[1]) + (a[2] * a[2] + a[3] * a[3]) + (b[0] * b[0] + b[1] * b[1]) + (b[2] * b[2] + b[3] * b[3]); }
                if (!f32out) { ss += sx(ss, 16, lane); ss += sx(ss, 32, lane);
                    if (fq == 0) xch[(ai * HALF + wr * 64 + m * 16 + fr) * 4 + wc] = ss; } }
        }
        if (!f32out) {
            asm volatile("s_waitcnt lgkmcnt(0)" ::: "memory"); __builtin_amdgcn_s_barrier(); asm volatile("" ::: "memory");
            const int tl = (wr * 4 + wc) * 64 + lane;
            if (tl < 256) { const f32x4 v = *(const LAS f32x4*)(xch + tl * 4); ssq[4 * (size_t)(u.pm * BM + tl) + u.pn] = ((v.x + v.y) + v.z) + v.w; }
        }
    }
};
__device__ __forceinline__ float dpp_ror1(float v) { return __builtin_bit_cast(float, __builtin_amdgcn_update_dpp(0, __builtin_bit_cast(int, v), 0x121, 0xf, 0xf, false)); }
typedef _Float16 h2_t __attribute__((ext_vector_type(2)));
__device__ __forceinline__ int dppi_ror1(int v) { return __builtin_amdgcn_update_dpp(0, v, 0x121, 0xf, 0xf, false); }
__device__ __forceinline__ int dppi_ror2(int v) { return __builtin_amdgcn_update_dpp(0, v, 0x122, 0xf, 0xf, false); }
__device__ __forceinline__ int dppi_shr1(int oldv, int v) { return __builtin_amdgcn_update_dpp(oldv, v, 0x111, 0xf, 0xf, false); }
__device__ __forceinline__ int dppi_shr2(int oldv, int v) { return __builtin_amdgcn_update_dpp(oldv, v, 0x112, 0xf, 0xf, false); }
__device__ __forceinline__ int pkh(float a, float b) { return __builtin_bit_cast(int, __builtin_amdgcn_cvt_pkrtz(a, b)); }
__device__ __forceinline__ float dpp_shr1(float oldv, float v) { return __builtin_bit_cast(float, __builtin_amdgcn_update_dpp(__builtin_bit_cast(int, oldv), __builtin_bit_cast(int, v), 0x111, 0xf, 0xf, false)); }
__device__ __forceinline__ float dpp_shr2(float oldv, float v) { return __builtin_bit_cast(float, __builtin_amdgcn_update_dpp(__builtin_bit_cast(int, oldv), __builtin_bit_cast(int, v), 0x112, 0xf, 0xf, false)); }
__device__ __forceinline__ float dpp_ror2(float v) { return __builtin_bit_cast(float, __builtin_amdgcn_update_dpp(0, __builtin_bit_cast(int, v), 0x122, 0xf, 0xf, false)); }
struct EpiConvGlu {
    static constexpr bool MIDK = false;
    bf16_t* act; const float* cw; const float* cb; LAS float* xch; const float* ssq; float* u4;
    __device__ __forceinline__ void operator()(f32x4 (&acc)[2][2][4][2], const Unit& u, int wr, int wc, int fr, int fq) const {
        const int colw = wc * 32 + 8 * fq;
#pragma unroll
        for (int ai = 0; ai < 2; ++ai)
#pragma unroll
            for (int m = 0; m < 4; ++m) { const int t = u.pm * 256 + ai * HALF + wr * 64 + m * 16 + fr;
                const float rs = 1.f / sqrtf(sum4(ssq + 4 * (size_t)t) * (1.f / DM) + EPS);
#pragma unroll
                for (int bj = 0; bj < 2; ++bj) { acc[ai][bj][m][0] *= rs; acc[ai][bj][m][1] *= rs; } }
        if (wr == 0 && fr < 2) {
#pragma unroll
            for (int bj = 0; bj < 2; ++bj)
#pragma unroll
                for (int n = 0; n < 2; ++n) *(f32x4*)(u4 + ((size_t)u.pm * 4 + fr) * (2 * DFF) + u.pn * 256 + bj * 128 + colw + 4 * n) = acc[0][bj][0][n];
        }
        if (wr == 1 && fr >= 14) {
#pragma unroll
            for (int bj = 0; bj < 2; ++bj)
#pragma unroll
                for (int n = 0; n < 2; ++n) *(f32x4*)(u4 + ((size_t)u.pm * 4 + 2 + (fr - 14)) * (2 * DFF) + u.pn * 256 + bj * 128 + colw + 4 * n) = acc[1][bj][3][n];
        }
        if (fr >= 14) {
#pragma unroll
            for (int ai = 0; ai < 2; ++ai)
#pragma unroll
                for (int bj = 0; bj < 2; ++bj)
#pragma unroll
                    for (int n = 0; n < 2; ++n) *(LAS f32x4*)(xch + ((ai * 2 + wr) * 2 + (fr - 14)) * 256 + bj * 128 + colw + 4 * n) = acc[ai][bj][3][n];
        }
        asm volatile("s_waitcnt lgkmcnt(0)" ::: "memory"); __builtin_amdgcn_s_barrier(); asm volatile("" ::: "memory");
        const int tbase = u.pm * 256;
        const bool seq_start = (u.pm & 15) == 0;
#pragma unroll
        for (int n = 0; n < 2; ++n) {
            const int ch = u.pn * 128 + colw + 4 * n;
            h2_t W0[4], W1[4], W2[4], Bb[4];
            { const f32x4 wg0 = *(const f32x4*)(cw + ch), wg1 = *(const f32x4*)(cw + 2 * DFF + ch), wg2 = *(const f32x4*)(cw + 4 * DFF + ch), bg = *(const f32x4*)(cb + ch);
              const f32x4 wv0 = *(const f32x4*)(cw + DFF + ch), wv1 = *(const f32x4*)(cw + 3 * DFF + ch), wv2 = *(const f32x4*)(cw + 5 * DFF + ch), bv = *(const f32x4*)(cb + DFF + ch);
#pragma unroll
              for (int j = 0; j < 4; ++j) { W0[j] = __builtin_bit_cast(h2_t, pkh(wg0[j], wv0[j])); W1[j] = __builtin_bit_cast(h2_t, pkh(wg1[j], wv1[j]));
                  W2[j] = __builtin_bit_cast(h2_t, pkh(wg2[j], wv2[j])); Bb[j] = __builtin_bit_cast(h2_t, pkh(bg[j], bv[j])); } }
#pragma unroll
            for (int ai = 0; ai < 2; ++ai) {
                const int strip = ai * 2 + wr;
                int X1[4] = {0, 0, 0, 0}, X2[4] = {0, 0, 0, 0};
                if (strip > 0 && fr < 2) {
                    const LAS float* xp = xch + ((strip - 1) * 2) * 256 + colw + 4 * n;
                    const f32x4 xg1 = *(const LAS f32x4*)(xp + 256), xv1 = *(const LAS f32x4*)(xp + 256 + 128);
                    const f32x4 xg2 = *(const LAS f32x4*)(xp + fr * 256), xv2 = *(const LAS f32x4*)(xp + fr * 256 + 128);
#pragma unroll
                    for (int j = 0; j < 4; ++j) { X1[j] = pkh(xg1[j], xv1[j]); X2[j] = pkh(xg2[j], xv2[j]); }
                }
                int Pp[4] = {0, 0, 0, 0};
#pragma unroll
                for (int m = 0; m < 4; ++m) {
                    const int lr = ai * HALF + wr * 64 + m * 16 + fr, t = tbase + lr, sp = t & (S - 1);
                    const int t0u = tbase + ai * HALF + wr * 64 + m * 16;
                    const bool has_start = ((t0u + 15) & (S - 1)) < 17;
                    float o[4];
#pragma unroll
                    for (int j = 0; j < 4; ++j) {
                        const int pc = pkh(acc[ai][0][m][n][j], acc[ai][1][m][n][j]);
                        const int o1_ = (m == 0) ? X1[j] : dppi_ror1(Pp[j]), o2_ = (m == 0) ? X2[j] : dppi_ror2(Pp[j]);
                        int s1 = dppi_shr1(o1_, pc), s2 = dppi_shr2(o2_, pc);
                        if (has_start) { s1 = sp >= 1 ? s1 : 0; s2 = sp >= 2 ? s2 : 0; }
                        const h2_t r = W2[j] * __builtin_bit_cast(h2_t, pc) + (W1[j] * __builtin_bit_cast(h2_t, s1) + (W0[j] * __builtin_bit_cast(h2_t, s2) + Bb[j]));
                        const float gg = (float)r.x, vv = (float)r.y;
                        o[j] = gg * __builtin_amdgcn_rcpf(1.f + __builtin_amdgcn_exp2f(-1.44269504f * gg)) * vv;
                        Pp[j] = pc;
                    }
                    if (lr >= 2 || seq_start) { u32x2 w; w.x = pk2(o[0], o[1]); w.y = pk2(o[2], o[3]); *(u32x2*)(act + (size_t)t * DFF + ch) = w; }
                }
            }
        }
    }
};
}

__device__ __forceinline__ s16x4 vtr(const LAS unsigned char* p) { typedef short v4i16 __attribute__((ext_vector_type(4))); return __builtin_bit_cast(s16x4, __builtin_amdgcn_ds_read_tr16_b64_v4i16((LAS v4i16*)p)); }

template <int DQK, bool CA>
__device__ __forceinline__ void attn_tile(const LAS unsigned char* kb_, const LAS unsigned char* vb_, const bf16x8 (&qf)[DQK / 16], f32x16& o0, f32x16& o1, float& mrun, f32x16& osum,
                                          const LAS float* tab, int dl, int qi, int h, float cscale) {
    constexpr int KP = DQK * 2 + 16, NS = DQK / 16;
    f32x16 s0, s1;
#pragma unroll
    for (int r = 0; r < 16; ++r) { s0[r] = 0.f; s1[r] = 0.f; }
#pragma unroll
    for (int s = 0; s < NS; ++s) {
        const bf16x8 a0 = *(const LAS bf16x8*)(kb_ + s * 32), a1 = *(const LAS bf16x8*)(kb_ + 32 * KP + s * 32);
        s0 = __builtin_amdgcn_mfma_f32_32x32x16_bf16(a0, qf[s], s0, 0, 0, 0);
        s1 = __builtin_amdgcn_mfma_f32_32x32x16_bf16(a1, qf[s], s1, 0, 0, 0);
    }
    const bool raw = !CA || dl >= 3;
    float off = 0.f;
    if (CA) {
        if (dl >= 3) off = tab[256];
        else {
#pragma unroll
            for (int r = 0; r < 16; ++r) { const int kj = (r & 3) + 8 * (r >> 2) + 4 * h; const int d0 = 64 * dl + qi - kj, d1 = d0 - 32;
                s0[r] = s0[r] * cscale + tab[(d0 < 128 ? d0 : 128) + 128]; s1[r] = s1[r] * cscale + tab[(d1 < 128 ? d1 : 128) + 128]; } }
    }
    float mx = s0[0];
#pragma unroll
    for (int r = 1; r < 16; ++r) mx = fmaxf(mx, s0[r]);
#pragma unroll
    for (int r = 0; r < 16; ++r) mx = fmaxf(mx, s1[r]);
    if (raw) mx = mx * cscale + off;
    { float ua = mx, ub = mx; asm volatile("s_nop 1\n\tv_permlane32_swap_b32 %0, %1" : "+v"(ua), "+v"(ub));
      mx = fmaxf(ua, ub); }
    const float mnew = fmaxf(mrun, mx);
    if (__builtin_amdgcn_ballot_w64(mnew > mrun) != 0ull) {
        const float alpha = __builtin_amdgcn_exp2f(mrun - mnew);
        osum[0] *= alpha;
#pragma unroll
        for (int r = 0; r < 16; ++r) { o0[r] *= alpha; o1[r] *= alpha; }
        mrun = mnew;
    }
    const bf16x8 ones = {16256, 16256, 16256, 16256, 16256, 16256, 16256, 16256};
#pragma unroll
    for (int kb = 0; kb < 2; ++kb) {
        f32x16& sk = kb == 0 ? s0 : s1;
        if (raw) { const float em = off - mrun;
#pragma unroll
            for (int r = 0; r < 16; ++r) sk[r] = __builtin_amdgcn_exp2f(__builtin_fmaf(sk[r], cscale, em)); }
        else {
#pragma unroll
            for (int r = 0; r < 16; ++r) sk[r] = __builtin_amdgcn_exp2f(sk[r] - mrun); }
        bf16x8 pf[2];
#pragma unroll
        for (int s2 = 0; s2 < 2; ++s2) {
            u32x4 a;
            a.x = pk2(sk[8 * s2 + 0], sk[8 * s2 + 1]); a.y = pk2(sk[8 * s2 + 2], sk[8 * s2 + 3]); a.z = pk2(sk[8 * s2 + 4], sk[8 * s2 + 5]); a.w = pk2(sk[8 * s2 + 6], sk[8 * s2 + 7]);
            pf[s2] = __builtin_bit_cast(bf16x8, a);
        }
#pragma unroll
        for (int s2 = 0; s2 < 2; ++s2) {
            const int ro = (32 * kb + 16 * s2) * 64;
            const s16x4 x0 = vtr(vb_ + ro), x1 = vtr(vb_ + ro + 8 * 64), y0 = vtr(vb_ + 4096 + ro), y1 = vtr(vb_ + 4096 + ro + 8 * 64);
            const bf16x8 va = {x0[0], x0[1], x0[2], x0[3], x1[0], x1[1], x1[2], x1[3]};
            const bf16x8 vb2 = {y0[0], y0[1], y0[2], y0[3], y1[0], y1[1], y1[2], y1[3]};
            o0 = __builtin_amdgcn_mfma_f32_32x32x16_bf16(va, pf[s2], o0, 0, 0, 0);
            o1 = __builtin_amdgcn_mfma_f32_32x32x16_bf16(vb2, pf[s2], o1, 0, 0, 0);
            osum = __builtin_amdgcn_mfma_f32_32x32x16_bf16(ones, pf[s2], osum, 0, 0, 0);
        }
    }
}

template <int DQK, bool CA>
__device__ __forceinline__ void attn_unit(LAS unsigned char* lds, const bf16_t* Qh, int qp, const bf16_t* Kh, int kp, const bf16_t* Vh, int vp, bf16_t* Oh,
                                          int tile_lo, int tile_hi, int q0, const float* bias, float cscale, float* gss,
                                          const bf16_t* cqrow0, const float* gqn, const int* posrow0) {
    constexpr int NCH = DQK / 8, KP = DQK * 2 + 16, KBUF = 64 * KP, BUF = KBUF + 8192, NS = DQK / 16;
    constexpr int TAB_OFF = 2 * BUF;
    int tid = threadIdx.x; asm volatile("" : "+v"(tid));
    const int w = __builtin_amdgcn_readfirstlane(tid >> 6), lane = tid & 63, h = lane >> 5, l31 = lane & 31;
    const int cq = (q0 >> 6) + (w >> 1);
    LAS float* tab = (LAS float*)(lds + TAB_OFF);
    if (CA) { if (tid < 257) tab[tid] = bias[tid] * 1.44269504f; }
    u32x4 kA0, kA1 = {0, 0, 0, 0}, vA, kB0, kB1 = {0, 0, 0, 0}, vB;
    const int vrow = tid >> 3, vch = tid & 7;
    const int krow0 = tid / NCH, kch0 = tid % NCH, krow1 = (tid + 512) / NCH, kch1 = (tid + 512) % NCH;
    const bf16_t* vsrc = Vh + (size_t)vrow * vp + vch * 8; const bf16_t* ksrc0 = Kh + (size_t)krow0 * kp + kch0 * 8; const bf16_t* ksrc1 = (tid < 256) ? Kh + (size_t)krow1 * kp + kch1 * 8 : ksrc0;
    const int kdst0 = krow0 * KP + kch0 * 16, kdst1 = krow1 * KP + kch1 * 16, vdst = KBUF + (vch >> 2) * 4096 + vrow * 64 + (vch & 3) * 16;
#define AT_GLOAD(K0, K1, V, tile) do { const int tl_ = (tile) < tile_hi ? (tile) : tile_hi; const size_t k0_ = (size_t)tl_ * 64; V = *(const u32x4*)(vsrc + k0_ * vp); K0 = *(const u32x4*)(ksrc0 + k0_ * kp); \
        if (NCH == 12) K1 = *(const u32x4*)(ksrc1 + k0_ * kp); } while (0)
#define AT_LSTORE(K0, K1, V, buf) do { LAS unsigned char* b_ = lds + (buf) * BUF; *(LAS u32x4*)(b_ + kdst0) = K0; if (NCH == 12 && tid < 256) *(LAS u32x4*)(b_ + kdst1) = K1; \
        *(LAS u32x4*)(b_ + vdst) = V; } while (0)
#define AT_BAR() do { asm volatile("s_waitcnt lgkmcnt(0)" ::: "memory"); __builtin_amdgcn_s_barrier(); asm volatile("" ::: "memory"); } while (0)
    AT_GLOAD(kA0, kA1, vA, tile_lo);
    bf16x8 qf[NS];
    { const bf16_t* qrow = Qh + (size_t)(q0 + 32 * w + l31) * qp + 8 * h;
#pragma unroll
      for (int s = 0; s < NS; ++s) qf[s] = *(const bf16x8*)(qrow + 16 * s); }
    if (!CA) {
        const int trow = q0 + 32 * w + l31;
        float ssc = 0.f;
        { const bf16_t* cq = cqrow0 + (size_t)trow * PW + 128 * h;
#pragma unroll
          for (int k = 0; k < 16; ++k) { const u32x4 a = *(const u32x4*)(cq + 8 * k);
              const float f0 = bflo(a.x), f1 = bfhi(a.x), f2 = bflo(a.y), f3 = bfhi(a.y), f4 = bflo(a.z), f5 = bfhi(a.z), f6 = bflo(a.w), f7 = bfhi(a.w);
              ssc += ((f0 * f0 + f1 * f1) + (f2 * f2 + f3 * f3)) + ((f4 * f4 + f5 * f5) + (f6 * f6 + f7 * f7)); } }
        { float ua = ssc, ub = ssc; asm volatile("s_nop 1\n\tv_permlane32_swap_b32 %0, %1" : "+v"(ua), "+v"(ub)); ssc = ua + ub; }
        const float rq = 1.f / sqrtf(ssc * (1.f / 256.f) + EPS);
        float z[NS][8]; float ssz = 0.f;
#pragma unroll
        for (int s = 0; s < NS; ++s) { const u32x4 a = __builtin_bit_cast(u32x4, qf[s]);
            z[s][0] = bflo(a.x) * rq; z[s][1] = bfhi(a.x) * rq; z[s][2] = bflo(a.y) * rq; z[s][3] = bfhi(a.y) * rq; z[s][4] = bflo(a.z) * rq; z[s][5] = bfhi(a.z) * rq; z[s][6] = bflo(a.w) * rq; z[s][7] = bfhi(a.w) * rq;
#pragma unroll
            for (int e = 0; e < 8; ++e) ssz += z[s][e] * z[s][e]; }
        { float ua = ssz, ub = ssz; asm volatile("s_nop 1\n\tv_permlane32_swap_b32 %0, %1" : "+v"(ua), "+v"(ub)); ssz = ua + ub; }
        const float rn = 1.f / sqrtf(ssz * (1.f / 96.f) + EPS);
#pragma unroll
        for (int s = 0; s < NS; ++s) { const f32x4 g0 = *(const f32x4*)(gqn + 16 * s + 8 * h), g1 = *(const f32x4*)(gqn + 16 * s + 8 * h + 4);
#pragma unroll
            for (int e = 0; e < 4; ++e) { z[s][e] *= rn * g0[e]; z[s][4 + e] *= rn * g1[e]; } }
        const float pos = (float)posrow0[trow];
#pragma unroll
        for (int e = 0; e < 8; ++e) {
            const float inv = exp2f(-(float)(8 * h + e) * (13.287712379549449f / 16.f)), ang = pos * inv;
            const double rr = (double)ang - 6.283185307179586 * rint((double)ang * 0.15915494309189535);
            const float c = __cosf((float)rr), sn = __sinf((float)rr), a = z[4][e], b = z[5][e];
            z[4][e] = a * c - b * sn; z[5][e] = a * sn + b * c; }
#pragma unroll
        for (int s = 0; s < NS; ++s) { u32x4 a; a.x = pk2(z[s][0], z[s][1]); a.y = pk2(z[s][2], z[s][3]); a.z = pk2(z[s][4], z[s][5]); a.w = pk2(z[s][6], z[s][7]); qf[s] = __builtin_bit_cast(bf16x8, a); }
    }
    f32x16 o0, o1;
#pragma unroll
    for (int r = 0; r < 16; ++r) { o0[r] = 0.f; o1[r] = 0.f; }
    float mrun = -1e30f; f32x16 osum;
#pragma unroll
    for (int r = 0; r < 16; ++r) osum[r] = 0.f;
    AT_LSTORE(kA0, kA1, vA, 0);
    AT_GLOAD(kA0, kA1, vA, tile_lo + 1);
    if (w >= 4) __builtin_amdgcn_s_setprio(1);
    AT_BAR();
    const int koff = l31 * KP + h * 16;
    const int voff = KBUF + (4 * h + ((lane & 15) >> 2)) * 64 + (((lane >> 4) & 1) * 16 + (lane & 3) * 4) * 2;
    const int qi = 32 * (w & 1) + l31;
#define AT_BODY(tile, L0, L1, LV, S0, S1, SV, buf) do { \
        AT_GLOAD(L0, L1, LV, (tile) + 2); \
        const bool active_ = CA ? ((tile) >= cq - 8 && (tile) <= cq) : ((tile) <= cq); \
        if (active_) attn_tile<DQK, CA>(lds + (buf) * BUF + koff, lds + (buf) * BUF + voff, qf, o0, o1, mrun, osum, tab, cq - (tile), qi, h, cscale); \
        if ((tile) + 1 <= tile_hi) AT_LSTORE(S0, S1, SV, (buf) ^ 1); \
        AT_BAR(); } while (0)
    for (int tile = tile_lo; tile <= tile_hi; tile += 2) {
        AT_BODY(tile, kB0, kB1, vB, kA0, kA1, vA, 0);
        if (tile + 1 <= tile_hi) AT_BODY(tile + 1, kA0, kA1, vA, kB0, kB1, vB, 1);
    }
    __builtin_amdgcn_s_setprio(0);
    const float inv = 1.f / osum[0];
    { float ss = 0.f;
#pragma unroll
      for (int r = 0; r < 16; ++r) { const float a = o0[r] * inv, b = o1[r] * inv; ss += a * a + b * b; }
      float ua = ss, ub = ss; asm volatile("s_nop 1\n\tv_permlane32_swap_b32 %0, %1" : "+v"(ua), "+v"(ub));
      if (h == 0) gss[16 * (size_t)(q0 + 32 * w + l31)] = ua + ub; }
    bf16_t* orow = Oh + (size_t)(q0 + 32 * w + l31) * DM + 4 * h;
#pragma unroll
    for (int i4 = 0; i4 < 4; ++i4) {
        u32x2 a, b;
        a.x = pk2(o0[4 * i4] * inv, o0[4 * i4 + 1] * inv); a.y = pk2(o0[4 * i4 + 2] * inv, o0[4 * i4 + 3] * inv);
        b.x = pk2(o1[4 * i4] * inv, o1[4 * i4 + 1] * inv); b.y = pk2(o1[4 * i4 + 2] * inv, o1[4 * i4 + 3] * inv);
        *(u32x2*)(orow + 8 * i4) = a; *(u32x2*)(orow + 32 + 8 * i4) = b;
    }
#undef AT_GLOAD
#undef AT_LSTORE
#undef AT_BAR
#undef AT_BODY
}

#define XB_TMO      128
#define XB_XCNT(j)  (256  + 64 * (j))
#define XB_XSUB(j)  (1280 + 64 * (j))
#define XB_XGEN(j)  (2304 + 64 * (j))
#define XB_TOP      3328
#define XB_TOPGEN   3392
#define XCD_BAR_WORDS 3456
#define XB_SPIN_CAP (1u << 18)

__device__ __forceinline__ unsigned xb_ld(unsigned* p)              { return __hip_atomic_load(p, __ATOMIC_RELAXED, __HIP_MEMORY_SCOPE_AGENT); }
__device__ __forceinline__ unsigned xb_add(unsigned* p, unsigned v) { return __hip_atomic_fetch_add(p, v, __ATOMIC_RELAXED, __HIP_MEMORY_SCOPE_AGENT); }
__device__ __forceinline__ unsigned xb_xcc_id() { return (unsigned)__builtin_amdgcn_s_getreg((3 << 11) | 20) & 0xFu; }
#define XB_SPIN(cond, bar) do { unsigned _sp = 0; while (cond) { __builtin_amdgcn_s_sleep(1); \
    if ((++_sp & 255u) == 0u) { if (xb_ld(&(bar)[XB_TMO])) break; if (_sp > XB_SPIN_CAP) { atomicAdd(&(bar)[XB_TMO], 1u); break; } } } } while (0)

struct XcdBarrier {
    unsigned* bar; unsigned x;
    volatile LAS unsigned* st;
};

__device__ __forceinline__ XcdBarrier xcd_barrier_post(unsigned* bar, volatile LAS unsigned* st) {
    XcdBarrier b; b.bar = bar; b.x = xb_xcc_id(); b.st = st;
    if (threadIdx.x == 0) (void)xb_add(&bar[XB_XCNT(b.x)], 1u);
    return b;
}
__device__ __forceinline__ void xcd_barrier_complete(unsigned* bar, unsigned x, unsigned& nloc, unsigned& nx) {
    const unsigned G = gridDim.x * gridDim.y * gridDim.z;
    unsigned sum, cnt, mine, sp = 0u;
    for (;;) {
        sum = 0u; cnt = 0u; mine = 0u;
#pragma unroll
        for (unsigned j = 0; j < 16; ++j) { const unsigned c = xb_ld(&bar[XB_XCNT(j)]); sum += c; cnt += (c > 0u) ? 1u : 0u; mine = (j == x) ? c : mine; }
        if (sum == G) break;
        __builtin_amdgcn_s_sleep(1);
        if ((++sp & 255u) == 0u) { if (xb_ld(&bar[XB_TMO])) break; if (sp > XB_SPIN_CAP) { atomicAdd(&bar[XB_TMO], 1u); break; } }
    }
    nloc = mine > 0u ? mine : 1u; nx = cnt > 0u ? cnt : 1u;
}

__device__ __forceinline__ void xcd_barrier(const XcdBarrier& b) {
    asm volatile("s_waitcnt vmcnt(0)" ::: "memory");
    __syncthreads();
    if (threadIdx.x == 0) {
        unsigned* bar = b.bar;
        __builtin_amdgcn_s_waitcnt(0);
        unsigned nloc = b.st[0], nx = b.st[1];
        if (nloc == 0u) { xcd_barrier_complete(bar, b.x, nloc, nx); b.st[0] = nloc; b.st[1] = nx; }
        const unsigned old = xb_add(&bar[XB_XSUB(b.x)], 1u);
        const unsigned gen = old / nloc;
        if (old + 1u == (gen + 1u) * nloc) {
            __builtin_amdgcn_fence(__ATOMIC_RELEASE, "agent");
            asm volatile("s_waitcnt vmcnt(0)" ::: "memory");
            const unsigned og = xb_add(&bar[XB_TOP], 1u);
            const unsigned tg = og / nx;
            if (og + 1u == (tg + 1u) * nx) xb_add(&bar[XB_TOPGEN], 1u);
            else XB_SPIN(xb_ld(&bar[XB_TOPGEN]) == tg, bar);
            __builtin_amdgcn_fence(__ATOMIC_ACQUIRE, "agent");
            xb_add(&bar[XB_XGEN(b.x)], 1u);
            asm volatile("s_waitcnt vmcnt(0)" ::: "memory");
        } else {
            XB_SPIN(xb_ld(&bar[XB_XGEN(b.x)]) == gen, bar);
            __builtin_amdgcn_fence(__ATOMIC_ACQUIRE, "agent");
            asm volatile("s_waitcnt vmcnt(0)" ::: "memory");
        }
    }
    __syncthreads();
}

struct Args { const void* in[21]; float* out; unsigned char* ws; int ph_lo, ph_hi; };


__device__ __forceinline__ const void* karg(int i) {
    const __attribute__((address_space(4))) char* kp = (const __attribute__((address_space(4))) char*)__builtin_amdgcn_kernarg_segment_ptr();
    unsigned off = (unsigned)i * 8u; asm volatile("" : "+s"(off));
    return *(const void* const __attribute__((address_space(4)))*)(kp + off);
}

__device__ __forceinline__ float wave_sum_(float v, int lane) {
#pragma unroll
    for (int o = 1; o < 64; o <<= 1) v += sx(v, o, lane);
    return v;
}

__device__ __forceinline__ void transpose_item(const float* W, int K, int Nsrc, bf16_t* WT, const float* g0, const float* g1, int mode, int Nd, LAS float* scr, int item, int lane) {
    const int nblk = Nd / 32, kb = item / nblk, nb = item % nblk, k0 = 64 * kb, n0 = 32 * nb;
    int src;
    if (mode == 0) src = n0 < Nsrc ? n0 : -1;
    else if (mode == 4) { const int tq = n0 >> 8, p = n0 & 255, bj = p >> 7, wc = (p >> 5) & 3; src = (2 * tq + (wc & 1)) * 128 + (wc >> 1) * 64 + 32 * bj; }
    else if (mode == 3) {
        if (n0 < 416) src = n0; else if (n0 < 512) src = -1;
        else if (n0 < 1536) { const int tq = (n0 - 512) >> 8, p = (n0 - 512) & 255, bj = p >> 7, wc = (p >> 5) & 3; src = 416 + tq * 256 + wc * 64 + bj * 32; }
        else src = 416 + 1024 + (n0 - 1536);
    }
    else if (mode == 1) { const int hh = n0 / 128, d0 = n0 % 128; src = d0 < 96 ? hh * 96 + d0 : -1; }
    else { const int pn = n0 / 256, j0 = n0 % 256; src = j0 < 128 ? 128 * pn + j0 : DFF + 128 * pn + (j0 - 128); }
#pragma unroll
    for (int i = 0; i < 8; ++i) { const int kk = 8 * i + (lane >> 3), n4 = (lane & 7) * 4; const int k = k0 + kk;
        f32x4 v = {0.f, 0.f, 0.f, 0.f};
        if (src >= 0) { v = *(const f32x4*)(W + (size_t)k * Nsrc + src + n4); if (g0) v *= (g1 && k >= 512) ? g1[k - 512] : g0[k]; }
        scr[kk * 33 + n4] = v.x; scr[kk * 33 + n4 + 1] = v.y; scr[kk * 33 + n4 + 2] = v.z; scr[kk * 33 + n4 + 3] = v.w; }
    asm volatile("s_waitcnt lgkmcnt(0)" ::: "memory");
    const int c = lane & 7;
#pragma unroll
    for (int j = 0; j < 4; ++j) { const int n = (lane >> 3) + 8 * j; const LAS float* s = scr + (8 * c) * 33 + n;
        u32x4 o; o.x = pk2(s[0 * 33], s[1 * 33]); o.y = pk2(s[2 * 33], s[3 * 33]); o.z = pk2(s[4 * 33], s[5 * 33]); o.w = pk2(s[6 * 33], s[7 * 33]);
        *(u32x4*)(WT + (size_t)(n0 + n) * K + k0 + 8 * c) = o; }
    asm volatile("s_waitcnt lgkmcnt(0)" ::: "memory");
}

__global__ void __launch_bounds__(NTHR, 2) fwd_kernel(Args args) {
    extern __shared__ __attribute__((aligned(16))) unsigned char lds_raw[];
    LAS unsigned char* lds = (LAS unsigned char*)lds_raw;
    cg::grid_group grid = cg::this_grid();
    const int G = gridDim.x, bx = blockIdx.x, NGW = G * NWAVES;


    const int lo = args.ph_lo, hi = args.ph_hi;
    { int t0 = threadIdx.x; if (t0 < 4) ((volatile LAS unsigned*)(lds + MISC_OFF))[t0] = 0u; }
    __syncthreads();
    XcdBarrier xbar = xcd_barrier_post((unsigned*)karg(22) + CW_BAR, (volatile LAS unsigned*)(lds + MISC_OFF));
    int ph = 0; int l_ = -1;
#define PHASE_BEGIN if (ph >= lo && ph < hi) { int tid = threadIdx.x; asm volatile("" : "+v"(tid)); const int lane = tid & 63, wave = __builtin_amdgcn_readfirstlane(tid >> 6), gw = bx * NWAVES + wave; (void)lane; (void)gw; unsigned char* ws = (unsigned char*)karg(22); float* xo = (float*)karg(21); (void)xo; \
    bf16_t* HB = (bf16_t*)(ws + WS_HB); bf16_t* PB = (bf16_t*)(ws + WS_PB); bf16_t* QRAW = (bf16_t*)(ws + WS_QRAW); bf16_t* KVRAW = (bf16_t*)(ws + WS_KVRAW); bf16_t* KM = (bf16_t*)(ws + WS_KM); bf16_t* ACT = (bf16_t*)(ws + WS_ACT); \
    (void)HB; (void)PB; (void)QRAW; (void)KVRAW; (void)KM; (void)ACT; unsigned char* wl = ws + WS_W + (l_ < 0 ? 0 : l_) * W_LAYER; (void)wl; \
    const float* xsrc = (l_ <= 0) ? (const float*)karg(0) : (const float*)xo; (void)xsrc;
#define PHASE_END   if (ph + 1 < hi) { if (hi < 0) grid.sync(); else xcd_barrier(xbar);         } } ++ph;

    PHASE_BEGIN
    {
        LAS float* scr = (LAS float*)(lds + wave * 16384);
        constexpr int I_IN = 16 * 64, I_UQ = 4 * 24, I_UKV = 2 * 32, I_OUT = 16 * 32, I_UP = 16 * 176, I_DN = 44 * 32, I_L = I_IN + I_UQ + I_UKV + I_OUT + I_UP + I_DN;
        for (int it = gw; it < DEPTH * I_L; it += NGW) {
            const int l = it / I_L; int r = it % I_L;
            unsigned char* wl = ws + WS_W + l * W_LAYER;
            if (r < I_IN) { transpose_item((const float*)karg(3) + (size_t)l * DM * INC, DM, INC, (bf16_t*)(wl + WO_IN), (const float*)karg(2) + l * DM, nullptr, 3, PW, scr, r, lane); continue; } r -= I_IN;
            if (r < I_UQ) { transpose_item((const float*)karg(4) + (size_t)l * 256 * 768, 256, 768, (bf16_t*)(wl + WO_UQ), (const float*)karg(6) + l * 256, nullptr, 0, 768, scr, r, lane); continue; } r -= I_UQ;
            if (r < I_UKV) { transpose_item((const float*)karg(5) + (size_t)l * 128 * 1024, 128, 1024, (bf16_t*)(wl + WO_UKV), (const float*)karg(7) + l * 128, nullptr, 4, 1024, scr, r, lane); continue; } r -= I_UKV;
            if (r < I_OUT) { transpose_item((const float*)karg(15) + (size_t)l * DM * DM, DM, DM, (bf16_t*)(wl + WO_OUT), (const float*)karg(13) + l * 512, (const float*)karg(14) + l * 512, 0, DM, scr, r, lane); continue; } r -= I_OUT;
            if (r < I_UP) { transpose_item((const float*)karg(17) + (size_t)l * DM * 2 * DFF, DM, 2 * DFF, (bf16_t*)(wl + WO_UP), (const float*)karg(16) + l * DM, nullptr, 2, 2 * DFF, scr, r, lane); continue; } r -= I_UP;
            transpose_item((const float*)karg(20) + (size_t)l * DFF * DM, DFF, DM, (bf16_t*)(wl + WO_DOWN), nullptr, nullptr, 0, DM, scr, r, lane);
        }
    }

        {
            float* ssq = (float*)(ws + WS_SSQ);
            const float* x0 = (const float*)karg(0);
            for (int m = gw; m < T; m += NGW) {
                const f32x4* xr = (const f32x4*)(x0 + (size_t)m * DM) + lane;
                f32x4 v[4]; float s = 0.f;
#pragma unroll
                for (int j = 0; j < 4; ++j) { v[j] = xr[64 * j]; s += (v[j].x * v[j].x + v[j].y * v[j].y) + (v[j].z * v[j].z + v[j].w * v[j].w); }
                s = wave_sum_(s, lane);
                u32x2* o8 = (u32x2*)((bf16_t*)xo + (size_t)m * DM) + lane;
#pragma unroll
                for (int j = 0; j < 4; ++j) { u32x2 w; w.x = pk2(v[j].x, v[j].y); w.y = pk2(v[j].z, v[j].w); o8[64 * j] = w; }
                if (lane == 0) *(f32x4*)(ssq + 4 * (size_t)m) = (f32x4){s, 0.f, 0.f, 0.f};
            }
        }
    PHASE_END

    for (int l = 0; l < DEPTH; ++l) {
        l_ = l;


        PHASE_BEGIN
        { pg8::Gemm g{(const bf16_t*)xo, (const bf16_t*)(wl + WO_IN), DM, DM, 256, 0}; pg8::StaticOrder So; So.init(T / 256, PW / 256, G, bx);
          pg8::EpiProj E{PB, (const float*)(ws + WS_SSQ), (const float*)karg(10) + l * 64, (const float*)karg(11) + l * 64, (float*)(ws + WS_RKV)}; pg8::gemm_phase(lds, g, So, E); }
        PHASE_END

        PHASE_BEGIN
        { pg8::Gemm g{PB, (const bf16_t*)(wl + WO_UQ), PW, 256, 256, 0}; pg8::StaticOrder So; So.init(T / 256, 3, G, bx);
          pg8::EpiBf16 E{QRAW, 1024, nullptr}; pg8::gemm_phase(lds, g, So, E); }
        { pg8::Gemm g{PB + OFF_CKV, (const bf16_t*)(wl + WO_UKV), PW, 128, 256, 0}; pg8::StaticOrder So; So.init(T / 256, 4, G, bx);
          pg8::EpiKV E{KM, KVRAW, PB, (const float*)(ws + WS_RKV), (const float*)karg(9) + l * 96, (const int*)karg(1)}; pg8::gemm_phase(lds, g, So, E); }
        PHASE_END


        PHASE_BEGIN
        {
            const float* relb = (const float*)karg(12) + (size_t)l * 8 * 257;
            float* gssb = (float*)(ws + WS_GSS);
            for (int i = 0;; ++i) {
                const int L = i * G + bx; if (L >= 2048) break;
                if (L < 1024) {
                    const int r = L >> 8, jj = L & 255, gq_ = jj >> 6, bh = jj & 63, b = bh >> 3, hh = bh & 7;
                    const int qb = (r & 1) ? (12 - 4 * r) + gq_ : (15 - 4 * r) - gq_;
                    const size_t rb = (size_t)b * S;
                    attn_unit<96, false>(lds, QRAW + rb * 1024 + hh * 96, 1024, KM + rb * 768 + hh * 96, 768, KVRAW + rb * 1024 + hh * 128 + 64, 1024, HB + rb * DM + hh * 64,
                                         0, 4 * qb + 3, qb * 256, nullptr, 0.10206207261596575f * 1.44269504f, gssb + 16 * rb + hh, PB + rb * PW, (const float*)karg(8) + l * 96, (const int*)karg(1) + rb);
                } else {
                    const int v = L - 1024, bh = v & 63, cgp = v >> 6, b = bh >> 3, hh = bh & 7;
                    const size_t rb = (size_t)b * S;
                    const int tlo = 4 * cgp - 8 < 0 ? 0 : 4 * cgp - 8;
                    attn_unit<64, true>(lds, PB + rb * PW + OFF_CA + hh * 64, PW, PB + rb * PW + OFF_CA + 512 + hh * 64, PW, PB + rb * PW + OFF_CA + 1024 + hh * 64, PW, HB + rb * DM + 512 + hh * 64,
                                        tlo, 4 * cgp + 3, cgp * 256, relb + hh * 257, 0.125f * 1.44269504f, gssb + 16 * rb + 8 + hh, nullptr, nullptr, nullptr);
                }
            }
        }
        PHASE_END


        PHASE_BEGIN
        { pg8::Gemm g{HB, (const bf16_t*)(wl + WO_OUT), DM, DM, 256, 0}; pg8::StaticOrder So; So.init(T / 256, 4, G, bx);
          pg8::EpiResid<true> E{(const bf16_t*)xo, nullptr, (bf16_t*)(ws + WS_HB2), (float*)(ws + WS_SSQ) + 4 * (size_t)T, (const float*)(ws + WS_GSS), 0, (LAS float*)(lds + XCH_OFF)}; pg8::gemm_phase(lds, g, So, E); }
        PHASE_END


        PHASE_BEGIN
        { pg8::Gemm g{(const bf16_t*)(ws + WS_HB2), (const bf16_t*)(wl + WO_UP), DM, DM, 256, 0}; pg8::StaticOrder So; So.init(T / 256, 22, G, bx);
          pg8::EpiConvGlu E{ACT, (const float*)karg(18) + (size_t)l * 3 * 2 * DFF, (const float*)karg(19) + (size_t)l * 2 * DFF, (LAS float*)(lds + XCH_OFF), (const float*)(ws + WS_SSQ) + 4 * (size_t)T, (float*)(ws + WS_U4)};
          pg8::gemm_phase(lds, g, So, E); }
        PHASE_END

        PHASE_BEGIN
        { pg8::Gemm g{ACT, (const bf16_t*)(wl + WO_DOWN), DFF, DFF, 256, 0}; pg8::StaticOrder So; So.init(T / 256, 4, G, bx);
          {
              const float* u4 = (const float*)(ws + WS_U4); const float* cw = (const float*)karg(18) + (size_t)l * 3 * 2 * DFF; const float* cb = (const float*)karg(19) + (size_t)l * 2 * DFF;
              pg8::Unit uu;
              for (int i = 0; So.next(i, uu); ++i) {
                  const int pm = uu.pm; if ((pm & 15) == 0) continue;
                  for (int idx = tid; idx < 2 * DFF; idx += NTHR) {
                      const int r = idx / DFF, ch = idx % DFF;
                      const int pc = (ch >> 7) * 256 + (ch & 127);
                      const float* cur = u4 + ((size_t)pm * 4) * (2 * DFF); const float* prv = u4 + ((size_t)(pm - 1) * 4) * (2 * DFF);
                      const float g0 = cur[(size_t)r * (2 * DFF) + pc], v0 = cur[(size_t)r * (2 * DFF) + pc + 128];
                      const float g1 = r == 0 ? prv[(size_t)3 * (2 * DFF) + pc] : cur[pc], v1 = r == 0 ? prv[(size_t)3 * (2 * DFF) + pc + 128] : cur[pc + 128];
                      const float g2 = prv[(size_t)(2 + r) * (2 * DFF) + pc], v2 = prv[(size_t)(2 + r) * (2 * DFF) + pc + 128];
                      const float gg = cw[4 * DFF + ch] * g0 + cw[2 * DFF + ch] * g1 + cw[ch] * g2 + cb[ch];
                      const float vv = cw[5 * DFF + ch] * v0 + cw[3 * DFF + ch] * v1 + cw[DFF + ch] * v2 + cb[DFF + ch];
                      const float o = gg * __builtin_amdgcn_rcpf(1.f + __builtin_amdgcn_exp2f(-1.44269504f * gg)) * vv;
                      ACT[(size_t)(256 * pm + r) * DFF + ch] = (bf16_t)f2bf(o);
                  }
              }
              asm volatile("s_waitcnt vmcnt(0)" ::: "memory"); __syncthreads();
          }
          pg8::EpiResid<false> E{(const bf16_t*)(ws + WS_HB2), xo, (bf16_t*)xo, (float*)(ws + WS_SSQ), nullptr, l == DEPTH - 1 ? 1 : 0, (LAS float*)(lds + XCH_OFF)}; pg8::gemm_phase(lds, g, So, E); }
        PHASE_END
    }
}

constexpr int N_PHASES = 1 + 6 * DEPTH;
#ifndef N_LAUNCH_SPLIT
#define N_LAUNCH_SPLIT 0
#endif

extern "C" void kernel_launch(void* const* d_in, const int* in_sizes, int n_in, void* d_out, int out_size, void* d_ws, size_t ws_size, hipStream_t stream) {
    static int grid = 0;
    if (grid == 0) {
        if (n_in != 21 || ws_size < WS_END) { fprintf(stderr, "kernel_launch: unexpected n_in %d / ws %zu\n", n_in, ws_size); grid = -1; return; }
        int dev = 0, cus = 0, per_cu = 0;
        hipGetDevice(&dev); hipDeviceGetAttribute(&cus, hipDeviceAttributeMultiprocessorCount, dev);
        hipFuncSetAttribute((const void*)fwd_kernel, hipFuncAttributeMaxDynamicSharedMemorySize, LDS_BYTES);
        hipOccupancyMaxActiveBlocksPerMultiprocessor(&per_cu, (const void*)fwd_kernel, NTHR, LDS_BYTES);
        (void)hipGetLastError();
        if (per_cu < 1) { fprintf(stderr, "kernel_launch: occupancy query says %d blocks/CU\n", per_cu); per_cu = 1; }
        grid = cus;
    }
    if (grid < 0) return;
    if (hipMemsetAsync(d_ws, 0, CTL_ZERO_BYTES, stream) != hipSuccess) { fprintf(stderr, "memset failed\n"); return; }
    Args a{};
    for (int i = 0; i < 21; ++i) a.in[i] = d_in[i];
    a.out = (float*)d_out; a.ws = (unsigned char*)d_ws;
#if N_LAUNCH_SPLIT
    for (int p = 0; p < N_PHASES; ++p) { a.ph_lo = p; a.ph_hi = p + 1; void* kargs[] = {&a};
        hipError_t e = hipLaunchCooperativeKernel((const void*)fwd_kernel, dim3(grid), dim3(NTHR), kargs, LDS_BYTES, stream);
        if (e != hipSuccess) { fprintf(stderr, "launch %d failed: %s\n", p, hipGetErrorString(e)); break; } }
#else
    a.ph_lo = 0; a.ph_hi = N_PHASES; void* kargs[] = {&a};
    hipError_t e = hipLaunchCooperativeKernel((const void*)fwd_kernel, dim3(grid), dim3(NTHR), kargs, LDS_BYTES, stream);
    if (e != hipSuccess) fprintf(stderr, "cooperative launch failed: %s (grid %d)\n", hipGetErrorString(e), grid);
#endif
}
```

```cpp
#include <hip/hip_runtime.h>
#include <hip/hip_cooperative_groups.h>
#include <cstdio>
#include <cstdint>
namespace cg = cooperative_groups;

#define LAS __attribute__((address_space(3)))
typedef unsigned short bf16_t;
typedef short bf16x8 __attribute__((ext_vector_type(8)));
typedef short s16x4 __attribute__((ext_vector_type(4)));
typedef float f32x4 __attribute__((ext_vector_type(4)));
typedef float f32x16 __attribute__((ext_vector_type(16)));
typedef unsigned u32x4 __attribute__((ext_vector_type(4)));
typedef unsigned u32x2 __attribute__((ext_vector_type(2)));

constexpr int T = 32768, S = 4096, NB = 8, DM = 1024, DEPTH = 4;
constexpr int INC = 1952, PW = 2048;
constexpr int DFF = 2816;
constexpr float EPS = 1e-6f;
constexpr int OFF_CKV = 256, OFF_KR = 384, OFF_CA = 512;
constexpr int NTHR = 512, NWAVES = 8;

constexpr size_t MiB = 1u << 20;
constexpr size_t W_LAYER = (size_t)(4 * MiB + MiB / 2 + MiB / 4 + 2 * MiB + 11 * MiB + 5 * MiB + MiB / 2);
constexpr size_t WO_IN = 0, WO_UQ = 4 * MiB, WO_UKV = WO_UQ + MiB / 2, WO_OUT = WO_UKV + MiB / 4, WO_UP = WO_OUT + 2 * MiB, WO_DOWN = WO_UP + 11 * MiB;
constexpr size_t WS_W = 1 * MiB;
constexpr size_t WS_HB = 96 * MiB;
constexpr size_t WS_PB = 160 * MiB;
constexpr size_t WS_QRAW = 288 * MiB;
constexpr size_t WS_KVRAW = 352 * MiB;
constexpr size_t WS_KM = 416 * MiB;
constexpr size_t WS_ACT = 160 * MiB;
constexpr size_t WS_HB2 = 352 * MiB;
constexpr size_t WS_SSQ = 95 * MiB;
constexpr size_t WS_GSS = 464 * MiB;
constexpr size_t WS_U4 = 336 * MiB;
constexpr size_t WS_RKV = 466 * MiB;
constexpr size_t WS_END = 467 * MiB;
static_assert(WS_W + 4 * W_LAYER <= WS_HB, "weights fit");
static_assert(WS_ACT + (size_t)T * DFF * 2 <= WS_KVRAW, "act overlay");

constexpr int RING_BYTES = 131072;
constexpr int XCH_OFF = RING_BYTES;
constexpr int LDS_BYTES = 147456;
constexpr int MISC_OFF = RING_BYTES + 8192;
constexpr int CW_BAR = 4096;
constexpr size_t CTL_ZERO_BYTES = 65536;

__device__ __forceinline__ unsigned f2bf(float f) { unsigned u = __builtin_bit_cast(unsigned, f); return (u + 0x7fffu + ((u >> 16) & 1u)) >> 16; }
typedef float f32x2_t __attribute__((ext_vector_type(2)));
typedef __bf16 bf16x2_t __attribute__((ext_vector_type(2)));
__device__ __forceinline__ unsigned pk2a(float lo, float hi) { return __builtin_bit_cast(unsigned, __builtin_convertvector((f32x2_t){lo, hi}, bf16x2_t)); }
__device__ __forceinline__ unsigned pk2(float lo, float hi) { unsigned r; asm volatile("v_cvt_pk_bf16_f32 %0, %1, %2" : "=v"(r) : "v"(lo), "v"(hi)); return r; }
__device__ __forceinline__ float bflo(unsigned u) { return __builtin_bit_cast(float, u << 16); }
__device__ __forceinline__ float bfhi(unsigned u) { return __builtin_bit_cast(float, u & 0xffff0000u); }

__device__ __forceinline__ float sx(float v, int o, int lane) { return __builtin_bit_cast(float, __builtin_amdgcn_ds_bpermute((lane ^ o) << 2, __builtin_bit_cast(int, v))); }

__device__ __forceinline__ int tid_of(int wid0) { int l; asm volatile("v_mbcnt_lo_u32_b32 %0, -1, 0\n\tv_mbcnt_hi_u32_b32 %0, -1, %0" : "=v"(l)); return (wid0 << 6) | l; }

__device__ __forceinline__ float sum4(const float* p) { const f32x4 v = *(const f32x4*)p; return ((v.x + v.y) + v.z) + v.w; }

namespace pg8 {
constexpr int BM = 256, BK = 64, HALF = 128, HTB = HALF * BK * 2, STAGE_BYTES = 8 * HTB, NXCD = 8, WGM = 8;
__host__ __device__ __forceinline__ int lds_byte(int r, int c) { const int st = (r >> 4) * 2 + (c >> 5), rr = r & 15, cc = c & 31, ob = rr * 64 + cc * 2; return st * 1024 + (ob ^ (((ob >> 9) & 1) << 5)); }
__host__ __device__ __forceinline__ void stage_rc(int b, int& R, int& C) { const int st = b / 1024, sb = b % 1024, swz = sb ^ (((sb >> 9) & 1) << 5); R = (st >> 1) * 16 + swz / 64; C = (st & 1) * 32 + (swz % 64) / 2; }
__host__ __device__ __forceinline__ int perm32(int rho) { const int n = rho >> 4, i = rho & 15; return 8 * (i >> 2) + 4 * n + (i & 3); }

struct Unit { int pm, pn; };
struct Gemm { const bf16_t* A; const bf16_t* Bt; int lda, K, a_step, a_off; };

struct StaticOrder {
    int nM, nN, nwg, G, c;
    __device__ void init(int nM_, int nN_, int G_, int c_) { nM = nM_; nN = nN_; nwg = nM * nN; G = G_; c = c_; }
    __device__ bool next(int i, Unit& u) const {
        const long L = (long)i * G + c; if (L >= nwg) return false;
        int wgid = (int)L; { const int q = nwg / NXCD, r = nwg % NXCD, xcd = wgid % NXCD, off = wgid / NXCD; wgid = (xcd < r ? xcd * (q + 1) : r * (q + 1) + (xcd - r) * q) + off; }
        const int nig = WGM * nN, gid = wgid / nig, fm = gid * WGM, gsz = (nM - fm) < WGM ? (nM - fm) : WGM;
        u.pm = fm + ((wgid % nig) % gsz); u.pn = (wgid % nig) / gsz; return true;
    }
};

template <class Epi>
__device__ __forceinline__ void gemm_phase(LAS unsigned char* lds, const Gemm g, const StaticOrder& S, const Epi& E, int wid0) {
    int tid = tid_of(wid0);
    const int wid = __builtin_amdgcn_readfirstlane(tid >> 6), lane = tid & 63, wr = wid >> 2, wc = wid & 3, fr = lane & 15, fq = lane >> 4;
    const int K = g.K, nt = K / BK, lda = g.lda;
    unsigned voffA[2], voffB[2];
#pragma unroll
    for (int i = 0; i < 2; ++i) { int R, C; stage_rc(tid * 16 + i * 8192, R, C); const int Rb = (R & ~31) + perm32(R & 31);
        voffA[i] = (unsigned)(R * lda + C) * 2u; voffB[i] = (unsigned)(Rb * K + C) * 2u; }
    const size_t kstep = (size_t)(BK * 2);
    const size_t hstepA = (size_t)HALF * lda * 2, hstepB = (size_t)HALF * K * 2;
    const unsigned ldsw = (unsigned)wid * 1024u;
    const int aoff = lds_byte(wr * 64 + fr, fq * 8), boff = lds_byte(wc * 32 + fr, fq * 8);
#define PG8_SA(b, h) (((b) * 2 + (h)) * HTB)
#define PG8_SB(b, h) ((4 + (b) * 2 + (h)) * HTB)
#define PG8_STAGE(bufoff, gbase, voff) do { _Pragma("unroll") for (int _i = 0; _i < 2; ++_i) \
        __builtin_amdgcn_global_load_lds((const unsigned*)((const char*)(gbase) + (voff)[_i]), (LAS unsigned*)(lds + (bufoff) + ldsw + _i * 8192), 16, 0, 0); } while (0)
#define PG8_LDA(dst, b, h) do { _Pragma("unroll") for (int m = 0; m < 4; ++m) _Pragma("unroll") for (int k = 0; k < 2; ++k) dst[m][k] = *(const LAS bf16x8*)(lds + PG8_SA(b, h) + aoff + m * 2048 + k * 1024); } while (0)
#define PG8_LDB(dst, b, h) do { _Pragma("unroll") for (int n = 0; n < 2; ++n) _Pragma("unroll") for (int k = 0; k < 2; ++k) dst[n][k] = *(const LAS bf16x8*)(lds + PG8_SB(b, h) + boff + n * 2048 + k * 1024); } while (0)
#define PG8_MMA(ai, bj, At, Bt) do { __builtin_amdgcn_s_setprio(1); _Pragma("unroll") for (int m = 0; m < 4; ++m) _Pragma("unroll") for (int n = 0; n < 2; ++n) _Pragma("unroll") for (int k = 0; k < 2; ++k) \
        acc[ai][bj][m][n] = __builtin_amdgcn_mfma_f32_16x16x32_bf16(Bt[n][k], At[m][k], acc[ai][bj][m][n], 0, 0, 0); __builtin_amdgcn_s_setprio(0); } while (0)
#define PG8_WAIT_V(n) asm volatile("s_waitcnt vmcnt(" #n ")" ::: "memory")
#define PG8_WAIT_L(n) asm volatile("s_waitcnt lgkmcnt(" #n ")" ::: "memory")
#define PG8_BAR __builtin_amdgcn_s_barrier()
#define PG8_SCHED __builtin_amdgcn_sched_barrier(0)
    Unit cur, nxt; int ui = 0;
    if (!S.next(0, cur)) return;
    f32x4 acc[2][2][4][2];
#pragma unroll
    for (int a = 0; a < 2; ++a)
#pragma unroll
        for (int b = 0; b < 2; ++b)
#pragma unroll
            for (int m = 0; m < 4; ++m)
#pragma unroll
                for (int n = 0; n < 2; ++n) acc[a][b][m][n] = (f32x4){0.f, 0.f, 0.f, 0.f};
    bf16x8 At[4][2], B0[2][2], B1[2][2];
    const char* cA = (const char*)g.A + ((long)cur.pm * g.a_step + g.a_off) * (long)lda * 2; const char* cB = (const char*)g.Bt + (size_t)cur.pn * 2 * hstepB;
    PG8_STAGE(PG8_SB(0, 0), cB, voffB); PG8_STAGE(PG8_SB(0, 1), cB + hstepB, voffB); PG8_STAGE(PG8_SA(0, 0), cA, voffA); PG8_STAGE(PG8_SA(0, 1), cA + hstepA, voffA);
    if (wr == 1) PG8_BAR;
    PG8_WAIT_V(2); PG8_BAR;
    PG8_STAGE(PG8_SB(1, 0), cB + kstep, voffB); PG8_STAGE(PG8_SA(1, 0), cA + kstep, voffA); PG8_STAGE(PG8_SB(1, 1), cB + hstepB + kstep, voffB);
    PG8_WAIT_V(6); PG8_BAR;
    for (;;) {
        const bool has_next = S.next(ui + 1, nxt);
        const char* nA = has_next ? (const char*)g.A + ((long)nxt.pm * g.a_step + g.a_off) * (long)lda * 2 : cA; const char* nB = has_next ? (const char*)g.Bt + (size_t)nxt.pn * 2 * hstepB : cB;
        for (int t = 0; t < nt; t += 2) {
            if constexpr (Epi::MIDK) { if (t == nt / 2) { int t3 = tid_of(wid0); const int w3 = __builtin_amdgcn_readfirstlane(t3 >> 6); E.mid(acc, cur, w3 >> 2, t3 & 15); } }
            const bool last = (t == nt - 2);
            const char* a1 = cA + (size_t)(t + 1) * kstep;
            const char* a2 = last ? nA : cA + (size_t)(t + 2) * kstep; const char* b2 = last ? nB : cB + (size_t)(t + 2) * kstep;
            const char* a3 = a2 + kstep; const char* b3 = b2 + kstep;
            PG8_LDB(B0, 0, 0); PG8_LDB(B1, 0, 1); PG8_SCHED; PG8_LDA(At, 0, 0); PG8_STAGE(PG8_SA(1, 1), a1 + hstepA, voffA);
            PG8_WAIT_V(8); PG8_WAIT_L(0); PG8_BAR; PG8_MMA(0, 0, At, B0); PG8_MMA(0, 1, At, B1); PG8_BAR; PG8_SCHED;
            PG8_LDA(At, 0, 1); PG8_STAGE(PG8_SB(0, 0), b2, voffB); PG8_STAGE(PG8_SB(0, 1), b2 + hstepB, voffB); PG8_STAGE(PG8_SA(0, 0), a2, voffA);
            PG8_WAIT_V(8); PG8_WAIT_L(0); PG8_BAR; PG8_MMA(1, 0, At, B0); PG8_MMA(1, 1, At, B1); PG8_BAR; PG8_SCHED;
            PG8_LDB(B0, 1, 0); PG8_LDB(B1, 1, 1); PG8_SCHED; PG8_LDA(At, 1, 0); PG8_STAGE(PG8_SA(0, 1), a2 + hstepA, voffA);
            PG8_WAIT_V(8); PG8_WAIT_L(0); PG8_BAR; PG8_MMA(0, 0, At, B0); PG8_MMA(0, 1, At, B1); PG8_BAR; PG8_SCHED;
            PG8_LDA(At, 1, 1); PG8_STAGE(PG8_SB(1, 0), b3, voffB); PG8_STAGE(PG8_SB(1, 1), b3 + hstepB, voffB); PG8_STAGE(PG8_SA(1, 0), a3, voffA);
            PG8_WAIT_V(8); PG8_WAIT_L(0); PG8_BAR; PG8_MMA(1, 0, At, B0); PG8_MMA(1, 1, At, B1); PG8_BAR; PG8_SCHED;
        }
        if (wr == 0) PG8_BAR;
        { int t2 = tid_of(wid0); const int w2 = __builtin_amdgcn_readfirstlane(t2 >> 6), l2 = t2 & 63;
          E(acc, cur, w2 >> 2, w2 & 3, l2 & 15, l2 >> 4); }
        if (!has_next) break;
#pragma unroll
        for (int a = 0; a < 2; ++a)
#pragma unroll
            for (int b = 0; b < 2; ++b)
#pragma unroll
                for (int m = 0; m < 4; ++m)
#pragma unroll
                    for (int n = 0; n < 2; ++n) acc[a][b][m][n] = (f32x4){0.f, 0.f, 0.f, 0.f};
        cur = nxt; cA = nA; cB = nB; ++ui;
        if (wr == 1) PG8_BAR;
    }
    PG8_WAIT_V(0);
    PG8_BAR;
#undef PG8_SA
#undef PG8_SB
#undef PG8_STAGE
#undef PG8_LDA
#undef PG8_LDB
#undef PG8_MMA
#undef PG8_WAIT_V
#undef PG8_WAIT_L
#undef PG8_BAR
#undef PG8_SCHED
}

struct EpiProj {
    static constexpr bool MIDK = false;
    bf16_t* O; const float* ssq; const float* gq; const float* gk; float* rkvss;
    __device__ __forceinline__ void operator()(f32x4 (&acc)[2][2][4][2], const Unit& u, int wr, int wc, int fr, int fq) const {
        const int row0 = u.pm * BM + wr * 64 + fr, lane = fq * 16 + fr;
        const bool heads = u.pn >= 2 && u.pn < 6;
        f32x4 g[2][2];
        if (heads) { const float* gp = (u.pn < 4 ? gq : gk) + 8 * fq;
#pragma unroll
            for (int bj = 0; bj < 2; ++bj) { g[bj][0] = *(const f32x4*)(gp + 32 * bj); g[bj][1] = *(const f32x4*)(gp + 32 * bj + 4); } }
#pragma unroll
        for (int ai = 0; ai < 2; ++ai)
#pragma unroll
            for (int m = 0; m < 4; ++m) { const int row = row0 + ai * HALF + m * 16;
                const float rs = 1.f / sqrtf(sum4(ssq + 4 * (size_t)row) * (1.f / DM) + EPS);
                f32x4 v[2][2];
#pragma unroll
                for (int bj = 0; bj < 2; ++bj) { v[bj][0] = acc[ai][bj][m][0] * rs; v[bj][1] = acc[ai][bj][m][1] * rs; }
                if (heads) {
                    float ss = 0.f;
#pragma unroll
                    for (int bj = 0; bj < 2; ++bj)
#pragma unroll
                        for (int n = 0; n < 2; ++n) ss += (v[bj][n][0] * v[bj][n][0] + v[bj][n][1] * v[bj][n][1]) + (v[bj][n][2] * v[bj][n][2] + v[bj][n][3] * v[bj][n][3]);
                    ss += sx(ss, 16, lane); ss += sx(ss, 32, lane);
                    const float rn = 1.f / sqrtf(ss * (1.f / 64.f) + EPS);
                    bf16_t* rowp = O + (size_t)row * PW + u.pn * BM + wc * 64 + 8 * fq;
#pragma unroll
                    for (int bj = 0; bj < 2; ++bj) { const f32x4 a = v[bj][0] * rn * g[bj][0], b = v[bj][1] * rn * g[bj][1];
                        u32x4 w; w.x = pk2(a[0], a[1]); w.y = pk2(a[2], a[3]); w.z = pk2(b[0], b[1]); w.w = pk2(b[2], b[3]);
                        *(u32x4*)(rowp + 32 * bj) = w; }
                } else {
                    if (u.pn == 1) {
                        float ss = (v[0][0][0] * v[0][0][0] + v[0][0][1] * v[0][0][1]) + (v[0][0][2] * v[0][0][2] + v[0][0][3] * v[0][0][3]) + (v[0][1][0] * v[0][1][0] + v[0][1][1] * v[0][1][1]) + (v[0][1][2] * v[0][1][2] + v[0][1][3] * v[0][1][3]);
                        ss += sx(ss, 16, lane); ss += sx(ss, 32, lane);
                        if (fq == 0) rkvss[4 * (size_t)row + wc] = ss; }
                    bf16_t* rowp = O + (size_t)row * PW + u.pn * BM + wc * 32 + 8 * fq;
#pragma unroll
                    for (int bj = 0; bj < 2; ++bj) { u32x4 w; w.x = pk2(v[bj][0][0], v[bj][0][1]); w.y = pk2(v[bj][0][2], v[bj][0][3]); w.z = pk2(v[bj][1][0], v[bj][1][1]); w.w = pk2(v[bj][1][2], v[bj][1][3]);
                        *(u32x4*)(rowp + bj * HALF) = w; }
                }
            }
    }
};
struct EpiKV {
    static constexpr bool MIDK = false;
    bf16_t* KM; bf16_t* VO; const bf16_t* P; const float* rkvss; const float* gk; const int* pos;
    __device__ __forceinline__ void operator()(f32x4 (&acc)[2][2][4][2], const Unit& u, int wr, int wc, int fr, int fq) const {
        const int row0 = u.pm * BM + wr * 64 + fr, lane = fq * 16 + fr, head = 2 * u.pn + (wc & 1);
        if (wc >= 2) {
#pragma unroll
            for (int ai = 0; ai < 2; ++ai)
#pragma unroll
                for (int m = 0; m < 4; ++m) { const int row = row0 + ai * HALF + m * 16;
                    const float rkv = 1.f / sqrtf(sum4(rkvss + 4 * (size_t)row) * (1.f / 128.f) + EPS);
                    bf16_t* rowp = VO + (size_t)row * 1024 + head * 128 + 64 + 8 * fq;
#pragma unroll
                    for (int bj = 0; bj < 2; ++bj) { const f32x4 a = acc[ai][bj][m][0] * rkv, b = acc[ai][bj][m][1] * rkv;
                        u32x4 w; w.x = pk2(a[0], a[1]); w.y = pk2(a[2], a[3]); w.z = pk2(b[0], b[1]); w.w = pk2(b[2], b[3]);
                        *(u32x4*)(rowp + 32 * bj) = w; } }
        } else {
            const float inv0 = (fq & 1) ? 0.01f : 1.f;
#pragma unroll
            for (int ai = 0; ai < 2; ++ai)
#pragma unroll
                for (int m = 0; m < 4; ++m) { const int row = row0 + ai * HALF + m * 16;
                    const float rkv = 1.f / sqrtf(sum4(rkvss + 4 * (size_t)row) * (1.f / 128.f) + EPS);
                    const u32x4 kr = *(const u32x4*)(P + (size_t)row * PW + OFF_KR + 8 * fq);
                    float y[8] = {bflo(kr.x), bfhi(kr.x), bflo(kr.y), bfhi(kr.y), bflo(kr.z), bfhi(kr.z), bflo(kr.w), bfhi(kr.w)};
                    f32x4 v[2][2]; float ss = 0.f;
#pragma unroll
                    for (int bj = 0; bj < 2; ++bj)
#pragma unroll
                        for (int n = 0; n < 2; ++n) { v[bj][n] = acc[ai][bj][m][n] * rkv; ss += (v[bj][n][0] * v[bj][n][0] + v[bj][n][1] * v[bj][n][1]) + (v[bj][n][2] * v[bj][n][2] + v[bj][n][3] * v[bj][n][3]); }
#pragma unroll
                    for (int e = 0; e < 8; ++e) ss += y[e] * y[e];
                    ss += sx(ss, 16, lane); ss += sx(ss, 32, lane);
                    const float rn = 1.f / sqrtf(ss * (1.f / 96.f) + EPS);
                    bf16_t* krow = KM + (size_t)row * 768 + head * 96;
                    f32x4 g[2][2], gr[2];
                    { const float* gp = gk + 8 * fq;
#pragma unroll
                      for (int bj = 0; bj < 2; ++bj) { g[bj][0] = *(const f32x4*)(gp + 32 * bj); g[bj][1] = *(const f32x4*)(gp + 32 * bj + 4); }
                      gr[0] = *(const f32x4*)(gk + 64 + 8 * fq); gr[1] = *(const f32x4*)(gk + 64 + 8 * fq + 4); }
#pragma unroll
                    for (int bj = 0; bj < 2; ++bj) { const f32x4 a = v[bj][0] * rn * g[bj][0], b = v[bj][1] * rn * g[bj][1];
                        u32x4 w; w.x = pk2(a[0], a[1]); w.y = pk2(a[2], a[3]); w.z = pk2(b[0], b[1]); w.w = pk2(b[2], b[3]);
                        *(u32x4*)(krow + 32 * bj + 8 * fq) = w; }
                    const float posf = (float)pos[row];
                    float o[8];
#pragma unroll
                    for (int e = 0; e < 8; ++e) {
                        const float ye = y[e] * rn * gr[e >> 2][e & 3], yp = sx(ye, 32, lane);
                        constexpr float rp_[8] = {1.0f, 0.5623413251903491f, 0.31622776601683794f, 0.1778279410038923f, 0.1f, 0.05623413251903491f, 0.03162277660168379f, 0.01778279410038923f};
                        const float ang = posf * (inv0 * rp_[e]);
                        const double rr = (double)ang - 6.283185307179586 * rint((double)ang * 0.15915494309189535);
                        const float c = __cosf((float)rr), sn = __sinf((float)rr);
                        o[e] = fq < 2 ? ye * c - yp * sn : yp * sn + ye * c; }
                    u32x4 w; w.x = pk2(o[0], o[1]); w.y = pk2(o[2], o[3]); w.z = pk2(o[4], o[5]); w.w = pk2(o[6], o[7]);
                    *(u32x4*)(krow + 64 + 8 * fq) = w; }
        }
    }
};
struct EpiBf16 {
    static constexpr bool MIDK = false;
    bf16_t* O; int ldc; const float* ssq;
    __device__ __forceinline__ void operator()(f32x4 (&acc)[2][2][4][2], const Unit& u, int wr, int wc, int fr, int fq) const {
        const int row0 = u.pm * BM + wr * 64 + fr, col0 = u.pn * BM + wc * 32 + 8 * fq;
#pragma unroll
        for (int ai = 0; ai < 2; ++ai)
#pragma unroll
            for (int m = 0; m < 4; ++m) { const int row = row0 + ai * HALF + m * 16; bf16_t* rowp = O + (size_t)row * ldc + col0;
                const float rs = ssq ? 1.f / sqrtf(sum4(ssq + 4 * (size_t)row) * (1.f / DM) + EPS) : 1.f;
#pragma unroll
                for (int bj = 0; bj < 2; ++bj) { const f32x4 v0 = acc[ai][bj][m][0] * rs, v1 = acc[ai][bj][m][1] * rs;
                    u32x4 w; w.x = pk2(v0[0], v0[1]); w.y = pk2(v0[2], v0[3]); w.z = pk2(v1[0], v1[1]); w.w = pk2(v1[2], v1[3]);
                    *(u32x4*)(rowp + bj * HALF) = w; } }
    }
};
template <bool GN> struct EpiResid {
    static constexpr bool MIDK = GN;
    const bf16_t* xin; float* xout; bf16_t* xb; float* ssq; const float* gss; int f32out; LAS float* xch;
    __device__ __forceinline__ void mid(f32x4 (&acc)[2][2][4][2], const Unit& u, int wr, int fr) const {
#pragma unroll
        for (int ai = 0; ai < 2; ++ai)
#pragma unroll
            for (int m = 0; m < 4; ++m) { const int row = u.pm * BM + ai * HALF + wr * 64 + m * 16 + fr;
                const float* gp = gss + 16 * (size_t)row; const float ra = 1.f / sqrtf((sum4(gp) + sum4(gp + 4)) * (1.f / 512.f) + EPS), rb = 1.f / sqrtf((sum4(gp + 8) + sum4(gp + 12)) * (1.f / 512.f) + EPS), q = ra / rb;
#pragma unroll
                for (int bj = 0; bj < 2; ++bj) { acc[ai][bj][m][0] *= q; acc[ai][bj][m][1] *= q; } }
    }
    __device__ __forceinline__ void operator()(f32x4 (&acc)[2][2][4][2], const Unit& u, int wr, int wc, int fr, int fq) const {
        const int row0 = u.pm * BM + wr * 64 + fr, col0 = u.pn * BM + wc * 32 + 8 * fq, lane = fq * 16 + fr;
#pragma unroll
        for (int ai = 0; ai < 2; ++ai) {
            u32x4 pre[4][2];
#pragma unroll
            for (int m = 0; m < 4; ++m) { const size_t off = (size_t)(row0 + ai * HALF + m * 16) * DM + col0;
#pragma unroll
                for (int bj = 0; bj < 2; ++bj) pre[m][bj] = *(const u32x4*)(xin + off + bj * HALF); }
            asm volatile("" ::: "memory");
#pragma unroll
            for (int m = 0; m < 4; ++m) { const int row = row0 + ai * HALF + m * 16; const size_t off = (size_t)row * DM + col0;
                const float rb = GN ? 1.f / sqrtf((sum4(gss + 16 * (size_t)row + 8) + sum4(gss + 16 * (size_t)row + 12)) * (1.f / 512.f) + EPS) : 1.f;
                float ss = 0.f;
#pragma unroll
                for (int bj = 0; bj < 2; ++bj) {
                    const u32x4 p = pre[m][bj];
                    const f32x4 a = (f32x4){bflo(p.x), bfhi(p.x), bflo(p.y), bfhi(p.y)} + acc[ai][bj][m][0] * rb, b = (f32x4){bflo(p.z), bfhi(p.z), bflo(p.w), bfhi(p.w)} + acc[ai][bj][m][1] * rb;
                    if (f32out) { *(f32x4*)(xout + off + bj * HALF) = a; *(f32x4*)(xout + off + bj * HALF + 4) = b; }
                    else { u32x4 w; w.x = pk2(a[0], a[1]); w.y = pk2(a[2], a[3]); w.z = pk2(b[0], b[1]); w.w = pk2(b[2], b[3]);
                        *(u32x4*)(xb + off + bj * HALF) = w; }
                    ss += (a[0] * a[0] + a[1] * a[1]) + (a[2] * a[2] + a[3] * a[3]) + (b[0] * b[0] + b[1] * b[1]) + (b[2] * b[2] + b[3] * b[3]); }
                if (!f32out) { ss += sx(ss, 16, lane); ss += sx(ss, 32, lane);
                    if (fq == 0) xch[(ai * HALF + wr * 64 + m * 16 + fr) * 4 + wc] = ss; } }
        }
        if (!f32out) {
            asm volatile("s_waitcnt lgkmcnt(0)" ::: "memory"); __builtin_amdgcn_s_barrier(); asm volatile("" ::: "memory");
            const int tl = (wr * 4 + wc) * 64 + lane;
            if (tl < 256) { const f32x4 v = *(const LAS f32x4*)(xch + tl * 4); ssq[4 * (size_t)(u.pm * BM + tl) + u.pn] = ((v.x + v.y) + v.z) + v.w; }
        }
    }
};
__device__ __forceinline__ float dpp_ror1(float v) { return __builtin_bit_cast(float, __builtin_amdgcn_update_dpp(0, __builtin_bit_cast(int, v), 0x121, 0xf, 0xf, false)); }
typedef _Float16 h2_t __attribute__((ext_vector_type(2)));
__device__ __forceinline__ int dppi_ror1(int v) { return __builtin_amdgcn_update_dpp(0, v, 0x121, 0xf, 0xf, false); }
__device__ __forceinline__ int dppi_ror2(int v) { return __builtin_amdgcn_update_dpp(0, v, 0x122, 0xf, 0xf, false); }
__device__ __forceinline__ int dppi_shr1(int oldv, int v) { return __builtin_amdgcn_update_dpp(oldv, v, 0x111, 0xf, 0xf, false); }
__device__ __forceinline__ int dppi_shr2(int oldv, int v) { return __builtin_amdgcn_update_dpp(oldv, v, 0x112, 0xf, 0xf, false); }
__device__ __forceinline__ int pkh(float a, float b) { return __builtin_bit_cast(int, __builtin_amdgcn_cvt_pkrtz(a, b)); }
__device__ __forceinline__ float dpp_shr1(float oldv, float v) { return __builtin_bit_cast(float, __builtin_amdgcn_update_dpp(__builtin_bit_cast(int, oldv), __builtin_bit_cast(int, v), 0x111, 0xf, 0xf, false)); }
__device__ __forceinline__ float dpp_shr2(float oldv, float v) { return __builtin_bit_cast(float, __builtin_amdgcn_update_dpp(__builtin_bit_cast(int, oldv), __builtin_bit_cast(int, v), 0x112, 0xf, 0xf, false)); }
__device__ __forceinline__ float dpp_ror2(float v) { return __builtin_bit_cast(float, __builtin_amdgcn_update_dpp(0, __builtin_bit_cast(int, v), 0x122, 0xf, 0xf, false)); }
struct EpiConvGlu {
    static constexpr bool MIDK = false;
    bf16_t* act; const float* cw; const float* cb; LAS float* xch; const float* ssq; float* u4;
    __device__ __forceinline__ void operator()(f32x4 (&acc)[2][2][4][2], const Unit& u, int wr, int wc, int fr, int fq) const {
        const int colw = wc * 32 + 8 * fq;
#pragma unroll
        for (int ai = 0; ai < 2; ++ai)
#pragma unroll
            for (int m = 0; m < 4; ++m) { const int t = u.pm * 256 + ai * HALF + wr * 64 + m * 16 + fr;
                const float rs = 1.f / sqrtf(sum4(ssq + 4 * (size_t)t) * (1.f / DM) + EPS);
#pragma unroll
                for (int bj = 0; bj < 2; ++bj) { acc[ai][bj][m][0] *= rs; acc[ai][bj][m][1] *= rs; } }
        if (wr == 0 && fr < 2) {
#pragma unroll
            for (int bj = 0; bj < 2; ++bj)
#pragma unroll
                for (int n = 0; n < 2; ++n) *(f32x4*)(u4 + ((size_t)u.pm * 4 + fr) * (2 * DFF) + u.pn * 256 + bj * 128 + colw + 4 * n) = acc[0][bj][0][n];
        }
        if (wr == 1 && fr >= 14) {
#pragma unroll
            for (int bj = 0; bj < 2; ++bj)
#pragma unroll
                for (int n = 0; n < 2; ++n) *(f32x4*)(u4 + ((size_t)u.pm * 4 + 2 + (fr - 14)) * (2 * DFF) + u.pn * 256 + bj * 128 + colw + 4 * n) = acc[1][bj][3][n];
        }
        if (fr >= 14) {
#pragma unroll
            for (int ai = 0; ai < 2; ++ai)
#pragma unroll
                for (int bj = 0; bj < 2; ++bj)
#pragma unroll
                    for (int n = 0; n < 2; ++n) *(LAS f32x4*)(xch + ((ai * 2 + wr) * 2 + (fr - 14)) * 256 + bj * 128 + colw + 4 * n) = acc[ai][bj][3][n];
        }
        asm volatile("s_waitcnt lgkmcnt(0)" ::: "memory"); __builtin_amdgcn_s_barrier(); asm volatile("" ::: "memory");
        const int tbase = u.pm * 256;
        const bool seq_start = (u.pm & 15) == 0;
#pragma unroll
        for (int n = 0; n < 2; ++n) {
            const int ch = u.pn * 128 + colw + 4 * n;
            h2_t W0[4], W1[4], W2[4], Bb[4];
            { const f32x4 wg0 = *(const f32x4*)(cw + ch), wg1 = *(const f32x4*)(cw + 2 * DFF + ch), wg2 = *(const f32x4*)(cw + 4 * DFF + ch), bg = *(const f32x4*)(cb + ch);
              const f32x4 wv0 = *(const f32x4*)(cw + DFF + ch), wv1 = *(const f32x4*)(cw + 3 * DFF + ch), wv2 = *(const f32x4*)(cw + 5 * DFF + ch), bv = *(const f32x4*)(cb + DFF + ch);
#pragma unroll
              for (int j = 0; j < 4; ++j) { W0[j] = __builtin_bit_cast(h2_t, pkh(wg0[j], wv0[j])); W1[j] = __builtin_bit_cast(h2_t, pkh(wg1[j], wv1[j]));
                  W2[j] = __builtin_bit_cast(h2_t, pkh(wg2[j], wv2[j])); Bb[j] = __builtin_bit_cast(h2_t, pkh(bg[j], bv[j])); } }
#pragma unroll
            for (int ai = 0; ai < 2; ++ai) {
                const int strip = ai * 2 + wr;
                int X1[4] = {0, 0, 0, 0}, X2[4] = {0, 0, 0, 0};
                if (strip > 0 && fr < 2) {
                    const LAS float* xp = xch + ((strip - 1) * 2) * 256 + colw + 4 * n;
                    const f32x4 xg1 = *(const LAS f32x4*)(xp + 256), xv1 = *(const LAS f32x4*)(xp + 256 + 128);
                    const f32x4 xg2 = *(const LAS f32x4*)(xp + fr * 256), xv2 = *(const LAS f32x4*)(xp + fr * 256 + 128);
#pragma unroll
                    for (int j = 0; j < 4; ++j) { X1[j] = pkh(xg1[j], xv1[j]); X2[j] = pkh(xg2[j], xv2[j]); }
                }
                int Pp[4] = {0, 0, 0, 0};
#pragma unroll
                for (int m = 0; m < 4; ++m) {
                    const int lr = ai * HALF + wr * 64 + m * 16 + fr, t = tbase + lr, sp = t & (S - 1);
                    const int t0u = tbase + ai * HALF + wr * 64 + m * 16;
                    const bool has_start = ((t0u + 15) & (S - 1)) < 17;
                    float o[4];
#pragma unroll
                    for (int j = 0; j < 4; ++j) {
                        const int pc = pkh(acc[ai][0][m][n][j], acc[ai][1][m][n][j]);
                        const int o1_ = (m == 0) ? X1[j] : dppi_ror1(Pp[j]), o2_ = (m == 0) ? X2[j] : dppi_ror2(Pp[j]);
                        int s1 = dppi_shr1(o1_, pc), s2 = dppi_shr2(o2_, pc);
                        if (has_start) { s1 = sp >= 1 ? s1 : 0; s2 = sp >= 2 ? s2 : 0; }
                        const h2_t r = W2[j] * __builtin_bit_cast(h2_t, pc) + (W1[j] * __builtin_bit_cast(h2_t, s1) + (W0[j] * __builtin_bit_cast(h2_t, s2) + Bb[j]));
                        const float gg = (float)r.x, vv = (float)r.y;
                        o[j] = gg * __builtin_amdgcn_rcpf(1.f + __builtin_amdgcn_exp2f(-1.44269504f * gg)) * vv;
                        Pp[j] = pc;
                    }
                    if (lr >= 2 || seq_start) { u32x2 w; w.x = pk2(o[0], o[1]); w.y = pk2(o[2], o[3]); *(u32x2*)(act + (size_t)t * DFF + ch) = w; }
                }
            }
        }
    }
};
}

__device__ __forceinline__ s16x4 vtr(const LAS unsigned char* p) { typedef short v4i16 __attribute__((ext_vector_type(4))); return __builtin_bit_cast(s16x4, __builtin_amdgcn_ds_read_tr16_b64_v4i16((LAS v4i16*)p)); }

template <int DQK, bool CA, bool FIXM>
__device__ __forceinline__ void attn_tile(const LAS unsigned char* kb_, const LAS unsigned char* vb_, const bf16x8 (&qf)[DQK / 16], f32x16& o0, f32x16& o1, float& mrun, f32x16& osum,
                                          const LAS float* tab, int dl, int qi, int h, float cscale) {
    constexpr int KP = DQK * 2 + 16, NS = DQK / 16;
    f32x16 s0, s1;
#pragma unroll
    for (int r = 0; r < 16; ++r) { s0[r] = 0.f; s1[r] = 0.f; }
#pragma unroll
    for (int s = 0; s < NS; ++s) {
        const bf16x8 a0 = *(const LAS bf16x8*)(kb_ + s * 32), a1 = *(const LAS bf16x8*)(kb_ + 32 * KP + s * 32);
        s0 = __builtin_amdgcn_mfma_f32_32x32x16_bf16(a0, qf[s], s0, 0, 0, 0);
        s1 = __builtin_amdgcn_mfma_f32_32x32x16_bf16(a1, qf[s], s1, 0, 0, 0);
    }
    if (CA) {
        if (dl >= 3) { const float bc = tab[256];
#pragma unroll
            for (int r = 0; r < 16; ++r) { s0[r] = s0[r] * cscale + bc; s1[r] = s1[r] * cscale + bc; } }
        else {
#pragma unroll
            for (int r = 0; r < 16; ++r) { const int kj = (r & 3) + 8 * (r >> 2) + 4 * h; const int d0 = 64 * dl + qi - kj, d1 = d0 - 32;
                s0[r] = s0[r] * cscale + tab[(d0 < 128 ? d0 : 128) + 128]; s1[r] = s1[r] * cscale + tab[(d1 < 128 ? d1 : 128) + 128]; } }
    }
    if (!FIXM) {
        float mx = s0[0];
#pragma unroll
        for (int r = 1; r < 16; ++r) mx = fmaxf(mx, s0[r]);
#pragma unroll
        for (int r = 0; r < 16; ++r) mx = fmaxf(mx, s1[r]);
        if (!CA) mx *= cscale;
        { float ua = mx, ub = mx; asm volatile("s_nop 1\n\tv_permlane32_swap_b32 %0, %1" : "+v"(ua), "+v"(ub));
          mx = fmaxf(ua, ub); }
        const float mnew = fmaxf(mrun, mx);
        if (__builtin_amdgcn_ballot_w64(mnew > mrun) != 0ull) {
            const float alpha = __builtin_amdgcn_exp2f(mrun - mnew);
            osum[0] *= alpha;
#pragma unroll
            for (int r = 0; r < 16; ++r) { o0[r] *= alpha; o1[r] *= alpha; }
            mrun = mnew;
        }
    }
    const bf16x8 ones = {16256, 16256, 16256, 16256, 16256, 16256, 16256, 16256};
#pragma unroll
    for (int kb = 0; kb < 2; ++kb) {
        f32x16& sk = kb == 0 ? s0 : s1;
#pragma unroll
        for (int r = 0; r < 16; ++r) sk[r] = CA ? __builtin_amdgcn_exp2f(FIXM ? sk[r] : sk[r] - mrun) : __builtin_amdgcn_exp2f(__builtin_fmaf(sk[r], cscale, -mrun));
        bf16x8 pf[2];
#pragma unroll
        for (int s2 = 0; s2 < 2; ++s2) {
            u32x4 a;
            a.x = pk2a(sk[8 * s2 + 0], sk[8 * s2 + 1]); a.y = pk2a(sk[8 * s2 + 2], sk[8 * s2 + 3]); a.z = pk2a(sk[8 * s2 + 4], sk[8 * s2 + 5]); a.w = pk2a(sk[8 * s2 + 6], sk[8 * s2 + 7]);
            pf[s2] = __builtin_bit_cast(bf16x8, a);
        }
#pragma unroll
        for (int s2 = 0; s2 < 2; ++s2) {
            const int ro = (32 * kb + 16 * s2) * 64;
            const s16x4 x0 = vtr(vb_ + ro), x1 = vtr(vb_ + ro + 8 * 64), y0 = vtr(vb_ + 4096 + ro), y1 = vtr(vb_ + 4096 + ro + 8 * 64);
            const bf16x8 va = {x0[0], x0[1], x0[2], x0[3], x1[0], x1[1], x1[2], x1[3]};
            const bf16x8 vb2 = {y0[0], y0[1], y0[2], y0[3], y1[0], y1[1], y1[2], y1[3]};
            o0 = __builtin_amdgcn_mfma_f32_32x32x16_bf16(va, pf[s2], o0, 0, 0, 0);
            o1 = __builtin_amdgcn_mfma_f32_32x32x16_bf16(vb2, pf[s2], o1, 0, 0, 0);
            osum = __builtin_amdgcn_mfma_f32_32x32x16_bf16(ones, pf[s2], osum, 0, 0, 0);
        }
    }
}

template <int DQK, bool CA, bool FIXM>
__device__ __forceinline__ void attn_unit(LAS unsigned char* lds, const bf16_t* Qh, int qp, const bf16_t* Kh, int kp, const bf16_t* Vh, int vp, bf16_t* Oh,
                                          int tile_lo, int tile_hi, int q0, const float* bias, float cscale, float* gss,
                                          const bf16_t* cqrow0, const float* gqn, const int* posrow0, float mfix, int wid0) {
    constexpr int NCH = DQK / 8, KP = DQK * 2 + 16, KBUF = 64 * KP, BUF = KBUF + 8192, NS = DQK / 16;
    constexpr int TAB_OFF = 2 * BUF;
    int tid = tid_of(wid0);
    const int w = wid0, lane = tid & 63, h = lane >> 5, l31 = lane & 31;
    const int cq = (q0 >> 6) + (w >> 1);
    LAS float* tab = (LAS float*)(lds + TAB_OFF);
    if (CA) { if (tid < 257) tab[tid] = bias[tid] * 1.44269504f - (FIXM ? mfix : 0.f); }
    u32x4 kA0, kA1 = {0, 0, 0, 0}, vA, kB0, kB1 = {0, 0, 0, 0}, vB;
    const int vrow = tid >> 3, vch = tid & 7;
    const int krow0 = tid / NCH, kch0 = tid % NCH, krow1 = (tid + 512) / NCH, kch1 = (tid + 512) % NCH;
    const bf16_t* vsrc = Vh + (size_t)vrow * vp + vch * 8; const bf16_t* ksrc0 = Kh + (size_t)krow0 * kp + kch0 * 8; const bf16_t* ksrc1 = (tid < 256) ? Kh + (size_t)krow1 * kp + kch1 * 8 : ksrc0;
    const int kdst0 = krow0 * KP + kch0 * 16, kdst1 = krow1 * KP + kch1 * 16, vdst = KBUF + (vch >> 2) * 4096 + vrow * 64 + (vch & 3) * 16;
#define AT_GLOAD(K0, K1, V, tile) do { const int tl_ = (tile) < tile_hi ? (tile) : tile_hi; const size_t k0_ = (size_t)tl_ * 64; V = *(const u32x4*)(vsrc + k0_ * vp); K0 = *(const u32x4*)(ksrc0 + k0_ * kp); \
        if (NCH == 12) K1 = *(const u32x4*)(ksrc1 + k0_ * kp); } while (0)
#define AT_LSTORE(K0, K1, V, buf) do { LAS unsigned char* b_ = lds + (buf) * BUF; *(LAS u32x4*)(b_ + kdst0) = K0; if (NCH == 12 && tid < 256) *(LAS u32x4*)(b_ + kdst1) = K1; \
        *(LAS u32x4*)(b_ + vdst) = V; } while (0)
#define AT_BAR() do { asm volatile("s_waitcnt lgkmcnt(0)" ::: "memory"); __builtin_amdgcn_s_barrier(); asm volatile("" ::: "memory"); } while (0)
    AT_GLOAD(kA0, kA1, vA, tile_lo);
    bf16x8 qf[NS];
    { const bf16_t* qrow = Qh + (size_t)(q0 + 32 * w + l31) * qp + 8 * h;
#pragma unroll
      for (int s = 0; s < NS; ++s) qf[s] = *(const bf16x8*)(qrow + 16 * s); }
    if (!CA) {
        const int trow = q0 + 32 * w + l31;
        float ssc = 0.f;
        { const bf16_t* cq = cqrow0 + (size_t)trow * PW + 128 * h;
#pragma unroll
          for (int k = 0; k < 16; ++k) { const u32x4 a = *(const u32x4*)(cq + 8 * k);
              const float f0 = bflo(a.x), f1 = bfhi(a.x), f2 = bflo(a.y), f3 = bfhi(a.y), f4 = bflo(a.z), f5 = bfhi(a.z), f6 = bflo(a.w), f7 = bfhi(a.w);
              ssc += ((f0 * f0 + f1 * f1) + (f2 * f2 + f3 * f3)) + ((f4 * f4 + f5 * f5) + (f6 * f6 + f7 * f7)); } }
        { float ua = ssc, ub = ssc; asm volatile("s_nop 1\n\tv_permlane32_swap_b32 %0, %1" : "+v"(ua), "+v"(ub)); ssc = ua + ub; }
        const float rq = 1.f / sqrtf(ssc * (1.f / 256.f) + EPS);
        float z[NS][8]; float ssz = 0.f;
#pragma unroll
        for (int s = 0; s < NS; ++s) { const u32x4 a = __builtin_bit_cast(u32x4, qf[s]);
            z[s][0] = bflo(a.x) * rq; z[s][1] = bfhi(a.x) * rq; z[s][2] = bflo(a.y) * rq; z[s][3] = bfhi(a.y) * rq; z[s][4] = bflo(a.z) * rq; z[s][5] = bfhi(a.z) * rq; z[s][6] = bflo(a.w) * rq; z[s][7] = bfhi(a.w) * rq;
#pragma unroll
            for (int e = 0; e < 8; ++e) ssz += z[s][e] * z[s][e]; }
        { float ua = ssz, ub = ssz; asm volatile("s_nop 1\n\tv_permlane32_swap_b32 %0, %1" : "+v"(ua), "+v"(ub)); ssz = ua + ub; }
        const float rn = 1.f / sqrtf(ssz * (1.f / 96.f) + EPS);
#pragma unroll
        for (int s = 0; s < NS; ++s) { const f32x4 g0 = *(const f32x4*)(gqn + 16 * s + 8 * h), g1 = *(const f32x4*)(gqn + 16 * s + 8 * h + 4);
#pragma unroll
            for (int e = 0; e < 4; ++e) { z[s][e] *= rn * g0[e]; z[s][4 + e] *= rn * g1[e]; } }
        const float pos = (float)posrow0[trow];
#pragma unroll
        for (int e = 0; e < 8; ++e) {
            const float inv = exp2f(-(float)(8 * h + e) * (13.287712379549449f / 16.f)), ang = pos * inv;
            const double rr = (double)ang - 6.283185307179586 * rint((double)ang * 0.15915494309189535);
            const float c = __cosf((float)rr), sn = __sinf((float)rr), a = z[4][e], b = z[5][e];
            z[4][e] = a * c - b * sn; z[5][e] = a * sn + b * c; }
#pragma unroll
        for (int s = 0; s < NS; ++s) { u32x4 a; a.x = pk2a(z[s][0], z[s][1]); a.y = pk2a(z[s][2], z[s][3]); a.z = pk2a(z[s][4], z[s][5]); a.w = pk2a(z[s][6], z[s][7]); qf[s] = __builtin_bit_cast(bf16x8, a); }
    }
    f32x16 o0, o1;
#pragma unroll
    for (int r = 0; r < 16; ++r) { o0[r] = 0.f; o1[r] = 0.f; }
    float mrun = FIXM ? (CA ? 0.f : mfix) : -1e30f; f32x16 osum;
#pragma unroll
    for (int r = 0; r < 16; ++r) osum[r] = 0.f;
    AT_LSTORE(kA0, kA1, vA, 0);
    AT_GLOAD(kA0, kA1, vA, tile_lo + 1);
    if (w >= 4) __builtin_amdgcn_s_setprio(1);
    AT_BAR();
    const int koff = l31 * KP + h * 16;
    const int voff = KBUF + (4 * h + ((lane & 15) >> 2)) * 64 + (((lane >> 4) & 1) * 16 + (lane & 3) * 4) * 2;
    const int qi = 32 * (w & 1) + l31;
#define AT_BODY(tile, L0, L1, LV, S0, S1, SV, buf) do { \
        AT_GLOAD(L0, L1, LV, (tile) + 2); \
        const bool active_ = CA ? ((tile) >= cq - 8 && (tile) <= cq) : ((tile) <= cq); \
        if (active_) attn_tile<DQK, CA, FIXM>(lds + (buf) * BUF + koff, lds + (buf) * BUF + voff, qf, o0, o1, mrun, osum, tab, cq - (tile), qi, h, cscale); \
        if ((tile) + 1 <= tile_hi) AT_LSTORE(S0, S1, SV, (buf) ^ 1); \
        AT_BAR(); } while (0)
    for (int tile = tile_lo; tile <= tile_hi; tile += 2) {
        AT_BODY(tile, kB0, kB1, vB, kA0, kA1, vA, 0);
        if (tile + 1 <= tile_hi) AT_BODY(tile + 1, kA0, kA1, vA, kB0, kB1, vB, 1);
    }
    __builtin_amdgcn_s_setprio(0);
    const float inv = 1.f / osum[0];
    { float ss = 0.f;
#pragma unroll
      for (int r = 0; r < 16; ++r) { const float a = o0[r] * inv, b = o1[r] * inv; ss += a * a + b * b; }
      float ua = ss, ub = ss; asm volatile("s_nop 1\n\tv_permlane32_swap_b32 %0, %1" : "+v"(ua), "+v"(ub));
      if (h == 0) gss[16 * (size_t)(q0 + 32 * w + l31)] = ua + ub; }
    bf16_t* orow = Oh + (size_t)(q0 + 32 * w + l31) * DM + 4 * h;
#pragma unroll
    for (int i4 = 0; i4 < 4; ++i4) {
        u32x2 a, b;
        a.x = pk2a(o0[4 * i4] * inv, o0[4 * i4 + 1] * inv); a.y = pk2a(o0[4 * i4 + 2] * inv, o0[4 * i4 + 3] * inv);
        b.x = pk2a(o1[4 * i4] * inv, o1[4 * i4 + 1] * inv); b.y = pk2a(o1[4 * i4 + 2] * inv, o1[4 * i4 + 3] * inv);
        *(u32x2*)(orow + 8 * i4) = a; *(u32x2*)(orow + 32 + 8 * i4) = b;
    }
#undef AT_GLOAD
#undef AT_LSTORE
#undef AT_BAR
#undef AT_BODY
}

#define XB_TMO      128
#define XB_XCNT(j)  (256  + 64 * (j))
#define XB_XSUB(j)  (1280 + 64 * (j))
#define XB_XGEN(j)  (2304 + 64 * (j))
#define XB_TOP      3328
#define XB_TOPGEN   3392
#define XCD_BAR_WORDS 3456
#define XB_SPIN_CAP (1u << 18)

__device__ __forceinline__ unsigned xb_ld(unsigned* p)              { return __hip_atomic_load(p, __ATOMIC_RELAXED, __HIP_MEMORY_SCOPE_AGENT); }
__device__ __forceinline__ unsigned xb_add(unsigned* p, unsigned v) { return __hip_atomic_fetch_add(p, v, __ATOMIC_RELAXED, __HIP_MEMORY_SCOPE_AGENT); }
__device__ __forceinline__ unsigned xb_xcc_id() { return (unsigned)__builtin_amdgcn_s_getreg((3 << 11) | 20) & 0xFu; }
#define XB_SPIN(cond, bar) do { unsigned _sp = 0; while (cond) { __builtin_amdgcn_s_sleep(1); \
    if ((++_sp & 255u) == 0u) { if (xb_ld(&(bar)[XB_TMO])) break; if (_sp > XB_SPIN_CAP) { atomicAdd(&(bar)[XB_TMO], 1u); break; } } } } while (0)

struct XcdBarrier {
    unsigned* bar; unsigned x;
    volatile LAS unsigned* st;
};

__device__ __forceinline__ XcdBarrier xcd_barrier_post(unsigned* bar, volatile LAS unsigned* st) {
    XcdBarrier b; b.bar = bar; b.x = xb_xcc_id(); b.st = st;
    if (threadIdx.x == 0) (void)xb_add(&bar[XB_XCNT(b.x)], 1u);
    return b;
}
__device__ __forceinline__ void xcd_barrier_complete(unsigned* bar, unsigned x, unsigned& nloc, unsigned& nx) {
    const unsigned G = gridDim.x * gridDim.y * gridDim.z;
    unsigned sum, cnt, mine, sp = 0u;
    for (;;) {
        sum = 0u; cnt = 0u; mine = 0u;
#pragma unroll
        for (unsigned j = 0; j < 16; ++j) { const unsigned c = xb_ld(&bar[XB_XCNT(j)]); sum += c; cnt += (c > 0u) ? 1u : 0u; mine = (j == x) ? c : mine; }
        if (sum == G) break;
        __builtin_amdgcn_s_sleep(1);
        if ((++sp & 255u) == 0u) { if (xb_ld(&bar[XB_TMO])) break; if (sp > XB_SPIN_CAP) { atomicAdd(&bar[XB_TMO], 1u); break; } }
    }
    nloc = mine > 0u ? mine : 1u; nx = cnt > 0u ? cnt : 1u;
}

__device__ __forceinline__ void xcd_barrier(const XcdBarrier& b) {
    asm volatile("s_waitcnt vmcnt(0)" ::: "memory");
    __syncthreads();
    if (threadIdx.x == 0) {
        unsigned* bar = b.bar;
        __builtin_amdgcn_s_waitcnt(0);
        unsigned nloc = b.st[0], nx = b.st[1];
        if (nloc == 0u) { xcd_barrier_complete(bar, b.x, nloc, nx); b.st[0] = nloc; b.st[1] = nx; }
        const unsigned old = xb_add(&bar[XB_XSUB(b.x)], 1u);
        const unsigned gen = old / nloc;
        if (old + 1u == (gen + 1u) * nloc) {
            __builtin_amdgcn_fence(__ATOMIC_RELEASE, "agent");
            asm volatile("s_waitcnt vmcnt(0)" ::: "memory");
            const unsigned og = xb_add(&bar[XB_TOP], 1u);
            const unsigned tg = og / nx;
            if (og + 1u == (tg + 1u) * nx) xb_add(&bar[XB_TOPGEN], 1u);
            else XB_SPIN(xb_ld(&bar[XB_TOPGEN]) == tg, bar);
            __builtin_amdgcn_fence(__ATOMIC_ACQUIRE, "agent");
            xb_add(&bar[XB_XGEN(b.x)], 1u);
            asm volatile("s_waitcnt vmcnt(0)" ::: "memory");
        } else {
            XB_SPIN(xb_ld(&bar[XB_XGEN(b.x)]) == gen, bar);
            __builtin_amdgcn_fence(__ATOMIC_ACQUIRE, "agent");
            asm volatile("s_waitcnt vmcnt(0)" ::: "memory");
        }
    }
    __syncthreads();
}

struct Args { const void* in[21]; float* out; unsigned char* ws; int ph_lo, ph_hi; };


__device__ __forceinline__ const void* karg(int i) {
    const __attribute__((address_space(4))) char* kp = (const __attribute__((address_space(4))) char*)__builtin_amdgcn_kernarg_segment_ptr();
    unsigned off = (unsigned)i * 8u; asm volatile("" : "+s"(off));
    return *(const void* const __attribute__((address_space(4)))*)(kp + off);
}

__device__ __forceinline__ float wave_sum_(float v, int lane) {
#pragma unroll
    for (int o = 1; o < 64; o <<= 1) v += sx(v, o, lane);
    return v;
}

__device__ __forceinline__ void transpose_item(const float* W, int K, int Nsrc, bf16_t* WT, const float* g0, const float* g1, int mode, int Nd, LAS float* scr, int item, int lane) {
    const int nblk = Nd / 32, kb = item / nblk, nb = item % nblk, k0 = 64 * kb, n0 = 32 * nb;
    int src;
    if (mode == 0) src = n0 < Nsrc ? n0 : -1;
    else if (mode == 4) { const int tq = n0 >> 8, p = n0 & 255, bj = p >> 7, wc = (p >> 5) & 3; src = (2 * tq + (wc & 1)) * 128 + (wc >> 1) * 64 + 32 * bj; }
    else if (mode == 3) {
        if (n0 < 416) src = n0; else if (n0 < 512) src = -1;
        else if (n0 < 1536) { const int tq = (n0 - 512) >> 8, p = (n0 - 512) & 255, bj = p >> 7, wc = (p >> 5) & 3; src = 416 + tq * 256 + wc * 64 + bj * 32; }
        else src = 416 + 1024 + (n0 - 1536);
    }
    else if (mode == 1) { const int hh = n0 / 128, d0 = n0 % 128; src = d0 < 96 ? hh * 96 + d0 : -1; }
    else { const int pn = n0 / 256, j0 = n0 % 256; src = j0 < 128 ? 128 * pn + j0 : DFF + 128 * pn + (j0 - 128); }
#pragma unroll
    for (int i = 0; i < 8; ++i) { const int kk = 8 * i + (lane >> 3), n4 = (lane & 7) * 4; const int k = k0 + kk;
        f32x4 v = {0.f, 0.f, 0.f, 0.f};
        if (src >= 0) { v = *(const f32x4*)(W + (size_t)k * Nsrc + src + n4); if (g0) v *= (g1 && k >= 512) ? g1[k - 512] : g0[k]; }
        scr[kk * 33 + n4] = v.x; scr[kk * 33 + n4 + 1] = v.y; scr[kk * 33 + n4 + 2] = v.z; scr[kk * 33 + n4 + 3] = v.w; }
    asm volatile("s_waitcnt lgkmcnt(0)" ::: "memory");
    const int c = lane & 7;
#pragma unroll
    for (int j = 0; j < 4; ++j) { const int n = (lane >> 3) + 8 * j; const LAS float* s = scr + (8 * c) * 33 + n;
        u32x4 o; o.x = pk2(s[0 * 33], s[1 * 33]); o.y = pk2(s[2 * 33], s[3 * 33]); o.z = pk2(s[4 * 33], s[5 * 33]); o.w = pk2(s[6 * 33], s[7 * 33]);
        *(u32x4*)(WT + (size_t)(n0 + n) * K + k0 + 8 * c) = o; }
    asm volatile("s_waitcnt lgkmcnt(0)" ::: "memory");
}

__global__ void __launch_bounds__(NTHR, 2) fwd_kernel(Args args) {
    extern __shared__ __attribute__((aligned(16))) unsigned char lds_raw[];
    LAS unsigned char* lds = (LAS unsigned char*)lds_raw;
    cg::grid_group grid = cg::this_grid();
    const int G = gridDim.x, bx = blockIdx.x, NGW = G * NWAVES;


    const int lo = args.ph_lo, hi = args.ph_hi;
    const int wid0 = __builtin_amdgcn_readfirstlane(threadIdx.x >> 6);
    { int t0 = threadIdx.x; if (t0 < 4) ((volatile LAS unsigned*)(lds + MISC_OFF))[t0] = 0u; }
    __syncthreads();
    XcdBarrier xbar = xcd_barrier_post((unsigned*)karg(22) + CW_BAR, (volatile LAS unsigned*)(lds + MISC_OFF));
    int ph = 0; int l_ = -1;
#define PHASE_BEGIN if (ph >= lo && ph < hi) { int tid = tid_of(wid0); const int lane = tid & 63, wave = wid0, gw = bx * NWAVES + wave; (void)lane; (void)gw; unsigned char* ws = (unsigned char*)karg(22); float* xo = (float*)karg(21); (void)xo; \
    bf16_t* HB = (bf16_t*)(ws + WS_HB); bf16_t* PB = (bf16_t*)(ws + WS_PB); bf16_t* QRAW = (bf16_t*)(ws + WS_QRAW); bf16_t* KVRAW = (bf16_t*)(ws + WS_KVRAW); bf16_t* KM = (bf16_t*)(ws + WS_KM); bf16_t* ACT = (bf16_t*)(ws + WS_ACT); \
    (void)HB; (void)PB; (void)QRAW; (void)KVRAW; (void)KM; (void)ACT; unsigned char* wl = ws + WS_W + (l_ < 0 ? 0 : l_) * W_LAYER; (void)wl; \
    const float* xsrc = (l_ <= 0) ? (const float*)karg(0) : (const float*)xo; (void)xsrc;
#define PHASE_END   if (ph + 1 < hi) { if (hi < 0) grid.sync(); else xcd_barrier(xbar);         } } ++ph;

    PHASE_BEGIN
    {
        LAS float* scr = (LAS float*)(lds + wave * 16384);
        constexpr int I_IN = 16 * 64, I_UQ = 4 * 24, I_UKV = 2 * 32, I_OUT = 16 * 32, I_UP = 16 * 176, I_DN = 44 * 32, I_L = I_IN + I_UQ + I_UKV + I_OUT + I_UP + I_DN;
        for (int it = gw; it < DEPTH * I_L; it += NGW) {
            const int l = it / I_L; int r = it % I_L;
            unsigned char* wl = ws + WS_W + l * W_LAYER;
            if (r < I_IN) { transpose_item((const float*)karg(3) + (size_t)l * DM * INC, DM, INC, (bf16_t*)(wl + WO_IN), (const float*)karg(2) + l * DM, nullptr, 3, PW, scr, r, lane); continue; } r -= I_IN;
            if (r < I_UQ) { transpose_item((const float*)karg(4) + (size_t)l * 256 * 768, 256, 768, (bf16_t*)(wl + WO_UQ), (const float*)karg(6) + l * 256, nullptr, 0, 768, scr, r, lane); continue; } r -= I_UQ;
            if (r < I_UKV) { transpose_item((const float*)karg(5) + (size_t)l * 128 * 1024, 128, 1024, (bf16_t*)(wl + WO_UKV), (const float*)karg(7) + l * 128, nullptr, 4, 1024, scr, r, lane); continue; } r -= I_UKV;
            if (r < I_OUT) { transpose_item((const float*)karg(15) + (size_t)l * DM * DM, DM, DM, (bf16_t*)(wl + WO_OUT), (const float*)karg(13) + l * 512, (const float*)karg(14) + l * 512, 0, DM, scr, r, lane); continue; } r -= I_OUT;
            if (r < I_UP) { transpose_item((const float*)karg(17) + (size_t)l * DM * 2 * DFF, DM, 2 * DFF, (bf16_t*)(wl + WO_UP), (const float*)karg(16) + l * DM, nullptr, 2, 2 * DFF, scr, r, lane); continue; } r -= I_UP;
            transpose_item((const float*)karg(20) + (size_t)l * DFF * DM, DFF, DM, (bf16_t*)(wl + WO_DOWN), nullptr, nullptr, 0, DM, scr, r, lane);
        }
    }

        {
            float* ssq = (float*)(ws + WS_SSQ);
            const float* x0 = (const float*)karg(0);
            for (int m = gw; m < T; m += NGW) {
                const f32x4* xr = (const f32x4*)(x0 + (size_t)m * DM) + lane;
                f32x4 v[4]; float s = 0.f;
#pragma unroll
                for (int j = 0; j < 4; ++j) { v[j] = xr[64 * j]; s += (v[j].x * v[j].x + v[j].y * v[j].y) + (v[j].z * v[j].z + v[j].w * v[j].w); }
                s = wave_sum_(s, lane);
                u32x2* o8 = (u32x2*)((bf16_t*)xo + (size_t)m * DM) + lane;
#pragma unroll
                for (int j = 0; j < 4; ++j) { u32x2 w; w.x = pk2(v[j].x, v[j].y); w.y = pk2(v[j].z, v[j].w); o8[64 * j] = w; }
                if (lane == 0) *(f32x4*)(ssq + 4 * (size_t)m) = (f32x4){s, 0.f, 0.f, 0.f};
            }
        }
    PHASE_END

    for (int l = 0; l < DEPTH; ++l) {
        l_ = l;


        PHASE_BEGIN
        { pg8::Gemm g{(const bf16_t*)xo, (const bf16_t*)(wl + WO_IN), DM, DM, 256, 0}; pg8::StaticOrder So; So.init(T / 256, PW / 256, G, bx);
          pg8::EpiProj E{PB, (const float*)(ws + WS_SSQ), (const float*)karg(10) + l * 64, (const float*)karg(11) + l * 64, (float*)(ws + WS_RKV)}; pg8::gemm_phase(lds, g, So, E, wid0); }
        PHASE_END

        PHASE_BEGIN
        { pg8::Gemm g{PB, (const bf16_t*)(wl + WO_UQ), PW, 256, 256, 0}; pg8::StaticOrder So; So.init(T / 256, 3, G, bx);
          pg8::EpiBf16 E{QRAW, 1024, nullptr}; pg8::gemm_phase(lds, g, So, E, wid0); }
        { pg8::Gemm g{PB + OFF_CKV, (const bf16_t*)(wl + WO_UKV), PW, 128, 256, 0}; pg8::StaticOrder So; So.init(T / 256, 4, G, bx);
          pg8::EpiKV E{KM, KVRAW, PB, (const float*)(ws + WS_RKV), (const float*)karg(9) + l * 96, (const int*)karg(1)}; pg8::gemm_phase(lds, g, So, E, wid0); }
        PHASE_END


        PHASE_BEGIN
        {
            const float* relb = (const float*)karg(12) + (size_t)l * 8 * 257;
            float* gssb = (float*)(ws + WS_GSS);
            float bmla, bca;
            { const float* gq_ = (const float*)karg(8) + l * 96; const float* gk_ = (const float*)karg(9) + l * 96;
              const float* gcq_ = (const float*)karg(10) + l * 64; const float* gck_ = (const float*)karg(11) + l * 64;
              float a = fmaxf(fabsf(gq_[lane]), lane < 32 ? fabsf(gq_[64 + lane]) : 0.f), b = fmaxf(fabsf(gk_[lane]), lane < 32 ? fabsf(gk_[64 + lane]) : 0.f);
              float c = fabsf(gcq_[lane]), d = fabsf(gck_[lane]), e = -1e30f;
              for (int i = lane; i < 8 * 257; i += 64) e = fmaxf(e, relb[i]);
#pragma unroll
              for (int o = 1; o < 64; o <<= 1) { a = fmaxf(a, sx(a, o, lane)); b = fmaxf(b, sx(b, o, lane)); c = fmaxf(c, sx(c, o, lane)); d = fmaxf(d, sx(d, o, lane)); e = fmaxf(e, sx(e, o, lane)); }
              bmla = 96.f * a * b * (0.10206207261596575f * 1.44269504f) * 1.03f + 0.5f;
              bca = 64.f * c * d * (0.125f * 1.44269504f) * 1.03f + e * 1.44269504f + 0.5f; }
            bmla = __builtin_bit_cast(float, __builtin_amdgcn_readfirstlane(__builtin_bit_cast(int, bmla))); bca = __builtin_bit_cast(float, __builtin_amdgcn_readfirstlane(__builtin_bit_cast(int, bca)));
            const bool fixm = (bmla < 40.f) && (bca < 40.f) && (bca > -40.f);

            for (int i = 0;; ++i) {
                const int L = i * G + bx; if (L >= 2048) break;
                if (L < 1024) {
                    const int r = L >> 8, jj = L & 255, gq_ = jj >> 6, bh = jj & 63, b = bh >> 3, hh = bh & 7;
                    const int qb = (r & 1) ? (12 - 4 * r) + gq_ : (15 - 4 * r) - gq_;
                    const size_t rb = (size_t)b * S;
                    if (fixm) attn_unit<96, false, true>(lds, QRAW + rb * 1024 + hh * 96, 1024, KM + rb * 768 + hh * 96, 768, KVRAW + rb * 1024 + hh * 128 + 64, 1024, HB + rb * DM + hh * 64,
                                         0, 4 * qb + 3, qb * 256, nullptr, 0.10206207261596575f * 1.44269504f, gssb + 16 * rb + hh, PB + rb * PW, (const float*)karg(8) + l * 96, (const int*)karg(1) + rb, bmla, wid0);
                    else attn_unit<96, false, false>(lds, QRAW + rb * 1024 + hh * 96, 1024, KM + rb * 768 + hh * 96, 768, KVRAW + rb * 1024 + hh * 128 + 64, 1024, HB + rb * DM + hh * 64,
                                         0, 4 * qb + 3, qb * 256, nullptr, 0.10206207261596575f * 1.44269504f, gssb + 16 * rb + hh, PB + rb * PW, (const float*)karg(8) + l * 96, (const int*)karg(1) + rb, 0.f, wid0);
                } else {
                    const int v = L - 1024, bh = v & 63, cgp = v >> 6, b = bh >> 3, hh = bh & 7;
                    const size_t rb = (size_t)b * S;
                    const int tlo = 4 * cgp - 8 < 0 ? 0 : 4 * cgp - 8;
                    if (fixm) attn_unit<64, true, true>(lds, PB + rb * PW + OFF_CA + hh * 64, PW, PB + rb * PW + OFF_CA + 512 + hh * 64, PW, PB + rb * PW + OFF_CA + 1024 + hh * 64, PW, HB + rb * DM + 512 + hh * 64,
                                        tlo, 4 * cgp + 3, cgp * 256, relb + hh * 257, 0.125f * 1.44269504f, gssb + 16 * rb + 8 + hh, nullptr, nullptr, nullptr, bca, wid0);
                    else attn_unit<64, true, false>(lds, PB + rb * PW + OFF_CA + hh * 64, PW, PB + rb * PW + OFF_CA + 512 + hh * 64, PW, PB + rb * PW + OFF_CA + 1024 + hh * 64, PW, HB + rb * DM + 512 + hh * 64,
                                        tlo, 4 * cgp + 3, cgp * 256, relb + hh * 257, 0.125f * 1.44269504f, gssb + 16 * rb + 8 + hh, nullptr, nullptr, nullptr, 0.f, wid0);
                }
            }
        }
        PHASE_END


        PHASE_BEGIN
        { pg8::Gemm g{HB, (const bf16_t*)(wl + WO_OUT), DM, DM, 256, 0}; pg8::StaticOrder So; So.init(T / 256, 4, G, bx);
          pg8::EpiResid<true> E{(const bf16_t*)xo, nullptr, (bf16_t*)(ws + WS_HB2), (float*)(ws + WS_SSQ) + 4 * (size_t)T, (const float*)(ws + WS_GSS), 0, (LAS float*)(lds + XCH_OFF)}; pg8::gemm_phase(lds, g, So, E, wid0); }
        PHASE_END


        PHASE_BEGIN
        { pg8::Gemm g{(const bf16_t*)(ws + WS_HB2), (const bf16_t*)(wl + WO_UP), DM, DM, 256, 0}; pg8::StaticOrder So; So.init(T / 256, 22, G, bx);
          pg8::EpiConvGlu E{ACT, (const float*)karg(18) + (size_t)l * 3 * 2 * DFF, (const float*)karg(19) + (size_t)l * 2 * DFF, (LAS float*)(lds + XCH_OFF), (const float*)(ws + WS_SSQ) + 4 * (size_t)T, (float*)(ws + WS_U4)};
          pg8::gemm_phase(lds, g, So, E, wid0); }
        PHASE_END

        PHASE_BEGIN
        { pg8::Gemm g{ACT, (const bf16_t*)(wl + WO_DOWN), DFF, DFF, 256, 0}; pg8::StaticOrder So; So.init(T / 256, 4, G, bx);
          {
              const float* u4 = (const float*)(ws + WS_U4); const float* cw = (const float*)karg(18) + (size_t)l * 3 * 2 * DFF; const float* cb = (const float*)karg(19) + (size_t)l * 2 * DFF;
              pg8::Unit uu;
              for (int i = 0; So.next(i, uu); ++i) {
                  const int pm = uu.pm; if ((pm & 15) == 0) continue;
                  for (int idx = tid; idx < 2 * DFF; idx += NTHR) {
                      const int r = idx / DFF, ch = idx % DFF;
                      const int pc = (ch >> 7) * 256 + (ch & 127);
                      const float* cur = u4 + ((size_t)pm * 4) * (2 * DFF); const float* prv = u4 + ((size_t)(pm - 1) * 4) * (2 * DFF);
                      const float g0 = cur[(size_t)r * (2 * DFF) + pc], v0 = cur[(size_t)r * (2 * DFF) + pc + 128];
                      const float g1 = r == 0 ? prv[(size_t)3 * (2 * DFF) + pc] : cur[pc], v1 = r == 0 ? prv[(size_t)3 * (2 * DFF) + pc + 128] : cur[pc + 128];
                      const float g2 = prv[(size_t)(2 + r) * (2 * DFF) + pc], v2 = prv[(size_t)(2 + r) * (2 * DFF) + pc + 128];
                      const float gg = cw[4 * DFF + ch] * g0 + cw[2 * DFF + ch] * g1 + cw[ch] * g2 + cb[ch];
                      const float vv = cw[5 * DFF + ch] * v0 + cw[3 * DFF + ch] * v1 + cw[DFF + ch] * v2 + cb[DFF + ch];
                      const float o = gg * __builtin_amdgcn_rcpf(1.f + __builtin_amdgcn_exp2f(-1.44269504f * gg)) * vv;
                      ACT[(size_t)(256 * pm + r) * DFF + ch] = (bf16_t)f2bf(o);
                  }
              }
              asm volatile("s_waitcnt vmcnt(0)" ::: "memory"); __syncthreads();
          }
          pg8::EpiResid<false> E{(const bf16_t*)(ws + WS_HB2), xo, (bf16_t*)xo, (float*)(ws + WS_SSQ), nullptr, l == DEPTH - 1 ? 1 : 0, (LAS float*)(lds + XCH_OFF)}; pg8::gemm_phase(lds, g, So, E, wid0); }
        PHASE_END
    }
}

constexpr int N_PHASES = 1 + 6 * DEPTH;
#ifndef N_LAUNCH_SPLIT
#define N_LAUNCH_SPLIT 0
#endif

extern "C" void kernel_launch(void* const* d_in, const int* in_sizes, int n_in, void* d_out, int out_size, void* d_ws, size_t ws_size, hipStream_t stream) {
    static int grid = 0;
    if (grid == 0) {
        if (n_in != 21 || ws_size < WS_END) { fprintf(stderr, "kernel_launch: unexpected n_in %d / ws %zu\n", n_in, ws_size); grid = -1; return; }
        int dev = 0, cus = 0, per_cu = 0;
        hipGetDevice(&dev); hipDeviceGetAttribute(&cus, hipDeviceAttributeMultiprocessorCount, dev);
        hipFuncSetAttribute((const void*)fwd_kernel, hipFuncAttributeMaxDynamicSharedMemorySize, LDS_BYTES);
        hipOccupancyMaxActiveBlocksPerMultiprocessor(&per_cu, (const void*)fwd_kernel, NTHR, LDS_BYTES);
        (void)hipGetLastError();
        if (per_cu < 1) { fprintf(stderr, "kernel_launch: occupancy query says %d blocks/CU\n", per_cu); per_cu = 1; }
        grid = cus;
    }
    if (grid < 0) return;
    if (hipMemsetAsync(d_ws, 0, CTL_ZERO_BYTES, stream) != hipSuccess) { fprintf(stderr, "memset failed\n"); return; }
    Args a{};
    for (int i = 0; i < 21; ++i) a.in[i] = d_in[i];
    a.out = (float*)d_out; a.ws = (unsigned char*)d_ws;
#if N_LAUNCH_SPLIT
    for (int p = 0; p < N_PHASES; ++p) { a.ph_lo = p; a.ph_hi = p + 1; void* kargs[] = {&a};
        hipError_t e = hipLaunchCooperativeKernel((const void*)fwd_kernel, dim3(grid), dim3(NTHR), kargs, LDS_BYTES, stream);
        if (e != hipSuccess) { fprintf(stderr, "launch %d failed: %s\n", p, hipGetErrorString(e)); break; } }
#else
    a.ph_lo = 0; a.ph_hi = N_PHASES; void* kargs[] = {&a};
    hipError_t e = hipLaunchCooperativeKernel((const void*)fwd_kernel, dim3(grid), dim3(NTHR), kargs, LDS_BYTES, stream);
    if (e != hipSuccess) fprintf(stderr, "cooperative launch failed: %s (grid %d)\n", hipGetErrorString(e), grid);
#endif
}
```

```cpp
#include <hip/hip_runtime.h>
#include <hip/hip_cooperative_groups.h>
#include <cstdio>
#include <cstdint>
namespace cg = cooperative_groups;

#define LAS __attribute__((address_space(3)))
typedef unsigned short bf16_t;
typedef short bf16x8 __attribute__((ext_vector_type(8)));
typedef short s16x4 __attribute__((ext_vector_type(4)));
typedef float f32x4 __attribute__((ext_vector_type(4)));
typedef float f32x16 __attribute__((ext_vector_type(16)));
typedef unsigned u32x4 __attribute__((ext_vector_type(4)));
typedef unsigned u32x2 __attribute__((ext_vector_type(2)));

constexpr int T = 32768, S = 4096, NB = 8, DM = 1024, DEPTH = 4;
constexpr int INC = 1952, PW = 2048;
constexpr int DFF = 2816;
constexpr float EPS = 1e-6f;
constexpr int OFF_CKV = 256, OFF_KR = 384, OFF_CA = 512;
constexpr int NTHR = 512, NWAVES = 8;

constexpr size_t MiB = 1u << 20;
constexpr size_t W_LAYER = (size_t)(4 * MiB + MiB / 2 + MiB / 4 + 2 * MiB + 11 * MiB + 5 * MiB + MiB / 2);
constexpr size_t WO_IN = 0, WO_UQ = 4 * MiB, WO_UKV = WO_UQ + MiB / 2, WO_OUT = WO_UKV + MiB / 4, WO_UP = WO_OUT + 2 * MiB, WO_DOWN = WO_UP + 11 * MiB;
constexpr size_t WS_W = 1 * MiB;
constexpr size_t WS_HB = 96 * MiB;
constexpr size_t WS_PB = 160 * MiB;
constexpr size_t WS_QRAW = 288 * MiB;
constexpr size_t WS_KVRAW = 352 * MiB;
constexpr size_t WS_KM = 416 * MiB;
constexpr size_t WS_ACT = 160 * MiB;
constexpr size_t WS_HB2 = 352 * MiB;
constexpr size_t WS_SSQ = 95 * MiB;
constexpr size_t WS_GSS = 464 * MiB;
constexpr size_t WS_U4 = 336 * MiB;
constexpr size_t WS_RKV = 466 * MiB;
constexpr size_t WS_END = 467 * MiB;
static_assert(WS_W + 4 * W_LAYER <= WS_HB, "weights fit");
static_assert(WS_ACT + (size_t)T * DFF * 2 <= WS_KVRAW, "act overlay");

constexpr int RING_BYTES = 131072;
constexpr int XCH_OFF = RING_BYTES;
constexpr int LDS_BYTES = 147456;
constexpr int MISC_OFF = RING_BYTES + 8192;
constexpr int CW_BAR = 4096;
constexpr size_t CTL_ZERO_BYTES = 65536;

__device__ __forceinline__ unsigned f2bf(float f) { unsigned u = __builtin_bit_cast(unsigned, f); return (u + 0x7fffu + ((u >> 16) & 1u)) >> 16; }
typedef float f32x2_t __attribute__((ext_vector_type(2)));
typedef __bf16 bf16x2_t __attribute__((ext_vector_type(2)));
__device__ __forceinline__ unsigned pk2a(float lo, float hi) { return __builtin_bit_cast(unsigned, __builtin_convertvector((f32x2_t){lo, hi}, bf16x2_t)); }
__device__ __forceinline__ unsigned pk2(float lo, float hi) { unsigned r; asm volatile("v_cvt_pk_bf16_f32 %0, %1, %2" : "=v"(r) : "v"(lo), "v"(hi)); return r; }
__device__ __forceinline__ float bflo(unsigned u) { return __builtin_bit_cast(float, u << 16); }
__device__ __forceinline__ float bfhi(unsigned u) { return __builtin_bit_cast(float, u & 0xffff0000u); }

__device__ __forceinline__ float sx(float v, int o, int lane) { return __builtin_bit_cast(float, __builtin_amdgcn_ds_bpermute((lane ^ o) << 2, __builtin_bit_cast(int, v))); }

__device__ __forceinline__ int tid_of(int wid0) { int l; asm volatile("v_mbcnt_lo_u32_b32 %0, -1, 0\n\tv_mbcnt_hi_u32_b32 %0, -1, %0" : "=v"(l)); return (wid0 << 6) | l; }

__device__ __forceinline__ float sum4(const float* p) { const f32x4 v = *(const f32x4*)p; return ((v.x + v.y) + v.z) + v.w; }

namespace pg8 {
constexpr int BM = 256, BK = 64, HALF = 128, HTB = HALF * BK * 2, STAGE_BYTES = 8 * HTB, NXCD = 8, WGM = 8;
__host__ __device__ __forceinline__ int lds_byte(int r, int c) { const int st = (r >> 4) * 2 + (c >> 5), rr = r & 15, cc = c & 31, ob = rr * 64 + cc * 2; return st * 1024 + (ob ^ (((ob >> 9) & 1) << 5)); }
__host__ __device__ __forceinline__ void stage_rc(int b, int& R, int& C) { const int st = b / 1024, sb = b % 1024, swz = sb ^ (((sb >> 9) & 1) << 5); R = (st >> 1) * 16 + swz / 64; C = (st & 1) * 32 + (swz % 64) / 2; }
__host__ __device__ __forceinline__ int perm32(int rho) { const int n = rho >> 4, i = rho & 15; return 8 * (i >> 2) + 4 * n + (i & 3); }

struct Unit { int pm, pn; };
struct Gemm { const bf16_t* A; const bf16_t* Bt; int lda, K, a_step, a_off; };

struct StaticOrder {
    int nM, nN, nwg, G, c;
    __device__ void init(int nM_, int nN_, int G_, int c_) { nM = nM_; nN = nN_; nwg = nM * nN; G = G_; c = c_; }
    __device__ bool next(int i, Unit& u) const {
        const long L = (long)i * G + c; if (L >= nwg) return false;
        int wgid = (int)L; { const int q = nwg / NXCD, r = nwg % NXCD, xcd = wgid % NXCD, off = wgid / NXCD; wgid = (xcd < r ? xcd * (q + 1) : r * (q + 1) + (xcd - r) * q) + off; }
        const int nig = WGM * nN, gid = wgid / nig, fm = gid * WGM, gsz = (nM - fm) < WGM ? (nM - fm) : WGM;
        u.pm = fm + ((wgid % nig) % gsz); u.pn = (wgid % nig) / gsz; return true;
    }
};

template <class Epi>
__device__ __forceinline__ void gemm_phase(LAS unsigned char* lds, const Gemm g, const StaticOrder& S, const Epi& E, int wid0) {
    int tid = tid_of(wid0);
    const int wid = __builtin_amdgcn_readfirstlane(tid >> 6), lane = tid & 63, wr = wid >> 2, wc = wid & 3, fr = lane & 15, fq = lane >> 4;
    const int K = g.K, nt = K / BK, lda = g.lda;
    unsigned voffA[2], voffB[2];
#pragma unroll
    for (int i = 0; i < 2; ++i) { int R, C; stage_rc(tid * 16 + i * 8192, R, C); const int Rb = (R & ~31) + perm32(R & 31);
        voffA[i] = (unsigned)(R * lda + C) * 2u; voffB[i] = (unsigned)(Rb * K + C) * 2u; }
    const size_t kstep = (size_t)(BK * 2);
    const size_t hstepA = (size_t)HALF * lda * 2, hstepB = (size_t)HALF * K * 2;
    const unsigned ldsw = (unsigned)wid * 1024u;
    const int aoff = lds_byte(wr * 64 + fr, fq * 8), boff = lds_byte(wc * 32 + fr, fq * 8);
#define PG8_SA(b, h) (((b) * 2 + (h)) * HTB)
#define PG8_SB(b, h) ((4 + (b) * 2 + (h)) * HTB)
#define PG8_STAGE(bufoff, gbase, voff) do { _Pragma("unroll") for (int _i = 0; _i < 2; ++_i) \
        __builtin_amdgcn_global_load_lds((const unsigned*)((const char*)(gbase) + (voff)[_i]), (LAS unsigned*)(lds + (bufoff) + ldsw + _i * 8192), 16, 0, 0); } while (0)
#define PG8_LDA(dst, b, h) do { _Pragma("unroll") for (int m = 0; m < 4; ++m) _Pragma("unroll") for (int k = 0; k < 2; ++k) dst[m][k] = *(const LAS bf16x8*)(lds + PG8_SA(b, h) + aoff + m * 2048 + k * 1024); } while (0)
#define PG8_LDB(dst, b, h) do { _Pragma("unroll") for (int n = 0; n < 2; ++n) _Pragma("unroll") for (int k = 0; k < 2; ++k) dst[n][k] = *(const LAS bf16x8*)(lds + PG8_SB(b, h) + boff + n * 2048 + k * 1024); } while (0)
#define PG8_MMA(ai, bj, At, Bt) do { __builtin_amdgcn_s_setprio(1); _Pragma("unroll") for (int m = 0; m < 4; ++m) _Pragma("unroll") for (int n = 0; n < 2; ++n) _Pragma("unroll") for (int k = 0; k < 2; ++k) \
        acc[ai][bj][m][n] = __builtin_amdgcn_mfma_f32_16x16x32_bf16(Bt[n][k], At[m][k], acc[ai][bj][m][n], 0, 0, 0); __builtin_amdgcn_s_setprio(0); } while (0)
#define PG8_WAIT_V(n) asm volatile("s_waitcnt vmcnt(" #n ")" ::: "memory")
#define PG8_WAIT_L(n) asm volatile("s_waitcnt lgkmcnt(" #n ")" ::: "memory")
#define PG8_BAR __builtin_amdgcn_s_barrier()
#define PG8_SCHED __builtin_amdgcn_sched_barrier(0)
    Unit cur, nxt; int ui = 0;
    if (!S.next(0, cur)) return;
    f32x4 acc[2][2][4][2];
#pragma unroll
    for (int a = 0; a < 2; ++a)
#pragma unroll
        for (int b = 0; b < 2; ++b)
#pragma unroll
            for (int m = 0; m < 4; ++m)
#pragma unroll
                for (int n = 0; n < 2; ++n) acc[a][b][m][n] = (f32x4){0.f, 0.f, 0.f, 0.f};
    bf16x8 At[4][2], B0[2][2], B1[2][2];
    const char* cA = (const char*)g.A + ((long)cur.pm * g.a_step + g.a_off) * (long)lda * 2; const char* cB = (const char*)g.Bt + (size_t)cur.pn * 2 * hstepB;
    PG8_STAGE(PG8_SB(0, 0), cB, voffB); PG8_STAGE(PG8_SB(0, 1), cB + hstepB, voffB); PG8_STAGE(PG8_SA(0, 0), cA, voffA); PG8_STAGE(PG8_SA(0, 1), cA + hstepA, voffA);
    if (wr == 1) PG8_BAR;
    PG8_WAIT_V(2); PG8_BAR;
    PG8_STAGE(PG8_SB(1, 0), cB + kstep, voffB); PG8_STAGE(PG8_SA(1, 0), cA + kstep, voffA); PG8_STAGE(PG8_SB(1, 1), cB + hstepB + kstep, voffB);
    PG8_WAIT_V(6); PG8_BAR;
    for (;;) {
        const bool has_next = S.next(ui + 1, nxt);
        const char* nA = has_next ? (const char*)g.A + ((long)nxt.pm * g.a_step + g.a_off) * (long)lda * 2 : cA; const char* nB = has_next ? (const char*)g.Bt + (size_t)nxt.pn * 2 * hstepB : cB;
        for (int t = 0; t < nt; t += 2) {
            if constexpr (Epi::MIDK) { if (t == nt / 2) { int t3 = tid_of(wid0); const int w3 = __builtin_amdgcn_readfirstlane(t3 >> 6); E.mid(acc, cur, w3 >> 2, t3 & 15); } }
            const bool last = (t == nt - 2);
            const char* a1 = cA + (size_t)(t + 1) * kstep;
            const char* a2 = last ? nA : cA + (size_t)(t + 2) * kstep; const char* b2 = last ? nB : cB + (size_t)(t + 2) * kstep;
            const char* a3 = a2 + kstep; const char* b3 = b2 + kstep;
            PG8_LDB(B0, 0, 0); PG8_LDB(B1, 0, 1); PG8_SCHED; PG8_LDA(At, 0, 0); PG8_STAGE(PG8_SA(1, 1), a1 + hstepA, voffA);
            PG8_WAIT_V(8); PG8_WAIT_L(0); PG8_BAR; PG8_MMA(0, 0, At, B0); PG8_MMA(0, 1, At, B1); PG8_BAR; PG8_SCHED;
            PG8_LDA(At, 0, 1); PG8_STAGE(PG8_SB(0, 0), b2, voffB); PG8_STAGE(PG8_SB(0, 1), b2 + hstepB, voffB); PG8_STAGE(PG8_SA(0, 0), a2, voffA);
            PG8_WAIT_V(8); PG8_WAIT_L(0); PG8_BAR; PG8_MMA(1, 0, At, B0); PG8_MMA(1, 1, At, B1); PG8_BAR; PG8_SCHED;
            PG8_LDB(B0, 1, 0); PG8_LDB(B1, 1, 1); PG8_SCHED; PG8_LDA(At, 1, 0); PG8_STAGE(PG8_SA(0, 1), a2 + hstepA, voffA);
            PG8_WAIT_V(8); PG8_WAIT_L(0); PG8_BAR; PG8_MMA(0, 0, At, B0); PG8_MMA(0, 1, At, B1); PG8_BAR; PG8_SCHED;
            PG8_LDA(At, 1, 1); PG8_STAGE(PG8_SB(1, 0), b3, voffB); PG8_STAGE(PG8_SB(1, 1), b3 + hstepB, voffB); PG8_STAGE(PG8_SA(1, 0), a3, voffA);
            PG8_WAIT_V(8); PG8_WAIT_L(0); PG8_BAR; PG8_MMA(1, 0, At, B0); PG8_MMA(1, 1, At, B1); PG8_BAR; PG8_SCHED;
        }
        if (wr == 0) PG8_BAR;
        { int t2 = tid_of(wid0); const int w2 = __builtin_amdgcn_readfirstlane(t2 >> 6), l2 = t2 & 63;
          E(acc, cur, w2 >> 2, w2 & 3, l2 & 15, l2 >> 4); }
        if (!has_next) break;
#pragma unroll
        for (int a = 0; a < 2; ++a)
#pragma unroll
            for (int b = 0; b < 2; ++b)
#pragma unroll
                for (int m = 0; m < 4; ++m)
#pragma unroll
                    for (int n = 0; n < 2; ++n) acc[a][b][m][n] = (f32x4){0.f, 0.f, 0.f, 0.f};
        cur = nxt; cA = nA; cB = nB; ++ui;
        if (wr == 1) PG8_BAR;
    }
    PG8_WAIT_V(0);
    PG8_BAR;
#undef PG8_SA
#undef PG8_SB
#undef PG8_STAGE
#undef PG8_LDA
#undef PG8_LDB
#undef PG8_MMA
#undef PG8_WAIT_V
#undef PG8_WAIT_L
#undef PG8_BAR
#undef PG8_SCHED
}

struct EpiProj {
    static constexpr bool MIDK = false;
    bf16_t* O; const float* ssq; const float* gq; const float* gk; float* rkvss;
    __device__ __forceinline__ void operator()(f32x4 (&acc)[2][2][4][2], const Unit& u, int wr, int wc, int fr, int fq) const {
        const int row0 = u.pm * BM + wr * 64 + fr, lane = fq * 16 + fr;
        const bool heads = u.pn >= 2 && u.pn < 6;
        f32x4 g[2][2];
        if (heads) { const float* gp = (u.pn < 4 ? gq : gk) + 8 * fq;
#pragma unroll
            for (int bj = 0; bj < 2; ++bj) { g[bj][0] = *(const f32x4*)(gp + 32 * bj); g[bj][1] = *(const f32x4*)(gp + 32 * bj + 4); } }
#pragma unroll
        for (int ai = 0; ai < 2; ++ai)
#pragma unroll
            for (int m = 0; m < 4; ++m) { const int row = row0 + ai * HALF + m * 16;
                const float rs = 1.f / sqrtf(sum4(ssq + 4 * (size_t)row) * (1.f / DM) + EPS);
                f32x4 v[2][2];
#pragma unroll
                for (int bj = 0; bj < 2; ++bj) { v[bj][0] = acc[ai][bj][m][0] * rs; v[bj][1] = acc[ai][bj][m][1] * rs; }
                if (heads) {
                    float ss = 0.f;
#pragma unroll
                    for (int bj = 0; bj < 2; ++bj)
#pragma unroll
                        for (int n = 0; n < 2; ++n) ss += (v[bj][n][0] * v[bj][n][0] + v[bj][n][1] * v[bj][n][1]) + (v[bj][n][2] * v[bj][n][2] + v[bj][n][3] * v[bj][n][3]);
                    ss += sx(ss, 16, lane); ss += sx(ss, 32, lane);
                    const float rn = 1.f / sqrtf(ss * (1.f / 64.f) + EPS);
                    bf16_t* rowp = O + (size_t)row * PW + u.pn * BM + wc * 64 + 8 * fq;
#pragma unroll
                    for (int bj = 0; bj < 2; ++bj) { const f32x4 a = v[bj][0] * rn * g[bj][0], b = v[bj][1] * rn * g[bj][1];
                        u32x4 w; w.x = pk2(a[0], a[1]); w.y = pk2(a[2], a[3]); w.z = pk2(b[0], b[1]); w.w = pk2(b[2], b[3]);
                        *(u32x4*)(rowp + 32 * bj) = w; }
                } else {
                    if (u.pn == 1) {
                        float ss = (v[0][0][0] * v[0][0][0] + v[0][0][1] * v[0][0][1]) + (v[0][0][2] * v[0][0][2] + v[0][0][3] * v[0][0][3]) + (v[0][1][0] * v[0][1][0] + v[0][1][1] * v[0][1][1]) + (v[0][1][2] * v[0][1][2] + v[0][1][3] * v[0][1][3]);
                        ss += sx(ss, 16, lane); ss += sx(ss, 32, lane);
                        if (fq == 0) rkvss[4 * (size_t)row + wc] = ss; }
                    bf16_t* rowp = O + (size_t)row * PW + u.pn * BM + wc * 32 + 8 * fq;
#pragma unroll
                    for (int bj = 0; bj < 2; ++bj) { u32x4 w; w.x = pk2(v[bj][0][0], v[bj][0][1]); w.y = pk2(v[bj][0][2], v[bj][0][3]); w.z = pk2(v[bj][1][0], v[bj][1][1]); w.w = pk2(v[bj][1][2], v[bj][1][3]);
                        *(u32x4*)(rowp + bj * HALF) = w; }
                }
            }
    }
};
struct EpiKV {
    static constexpr bool MIDK = false;
    bf16_t* KM; bf16_t* VO; const bf16_t* P; const float* rkvss; const float* gk; const int* pos;
    __device__ __forceinline__ void operator()(f32x4 (&acc)[2][2][4][2], const Unit& u, int wr, int wc, int fr, int fq) const {
        const int row0 = u.pm * BM + wr * 64 + fr, lane = fq * 16 + fr, head = 2 * u.pn + (wc & 1);
        if (wc >= 2) {
#pragma unroll
            for (int ai = 0; ai < 2; ++ai)
#pragma unroll
                for (int m = 0; m < 4; ++m) { const int row = row0 + ai * HALF + m * 16;
                    const float rkv = 1.f / sqrtf(sum4(rkvss + 4 * (size_t)row) * (1.f / 128.f) + EPS);
                    bf16_t* rowp = VO + (size_t)row * 1024 + head * 128 + 64 + 8 * fq;
#pragma unroll
                    for (int bj = 0; bj < 2; ++bj) { const f32x4 a = acc[ai][bj][m][0] * rkv, b = acc[ai][bj][m][1] * rkv;
                        u32x4 w; w.x = pk2(a[0], a[1]); w.y = pk2(a[2], a[3]); w.z = pk2(b[0], b[1]); w.w = pk2(b[2], b[3]);
                        *(u32x4*)(rowp + 32 * bj) = w; } }
        } else {
            const float inv0 = (fq & 1) ? 0.01f : 1.f;
#pragma unroll
            for (int ai = 0; ai < 2; ++ai)
#pragma unroll
                for (int m = 0; m < 4; ++m) { const int row = row0 + ai * HALF + m * 16;
                    const float rkv = 1.f / sqrtf(sum4(rkvss + 4 * (size_t)row) * (1.f / 128.f) + EPS);
                    const u32x4 kr = *(const u32x4*)(P + (size_t)row * PW + OFF_KR + 8 * fq);
                    float y[8] = {bflo(kr.x), bfhi(kr.x), bflo(kr.y), bfhi(kr.y), bflo(kr.z), bfhi(kr.z), bflo(kr.w), bfhi(kr.w)};
                    f32x4 v[2][2]; float ss = 0.f;
#pragma unroll
                    for (int bj = 0; bj < 2; ++bj)
#pragma unroll
                        for (int n = 0; n < 2; ++n) { v[bj][n] = acc[ai][bj][m][n] * rkv; ss += (v[bj][n][0] * v[bj][n][0] + v[bj][n][1] * v[bj][n][1]) + (v[bj][n][2] * v[bj][n][2] + v[bj][n][3] * v[bj][n][3]); }
#pragma unroll
                    for (int e = 0; e < 8; ++e) ss += y[e] * y[e];
                    ss += sx(ss, 16, lane); ss += sx(ss, 32, lane);
                    const float rn = 1.f / sqrtf(ss * (1.f / 96.f) + EPS);
                    bf16_t* krow = KM + (size_t)row * 768 + head * 96;
                    f32x4 g[2][2], gr[2];
                    { const float* gp = gk + 8 * fq;
#pragma unroll
                      for (int bj = 0; bj < 2; ++bj) { g[bj][0] = *(const f32x4*)(gp + 32 * bj); g[bj][1] = *(const f32x4*)(gp + 32 * bj + 4); }
                      gr[0] = *(const f32x4*)(gk + 64 + 8 * fq); gr[1] = *(const f32x4*)(gk + 64 + 8 * fq + 4); }
#pragma unroll
                    for (int bj = 0; bj < 2; ++bj) { const f32x4 a = v[bj][0] * rn * g[bj][0], b = v[bj][1] * rn * g[bj][1];
                        u32x4 w; w.x = pk2(a[0], a[1]); w.y = pk2(a[2], a[3]); w.z = pk2(b[0], b[1]); w.w = pk2(b[2], b[3]);
                        *(u32x4*)(krow + 32 * bj + 8 * fq) = w; }
                    const float posf = (float)pos[row];
                    float o[8];
#pragma unroll
                    for (int e = 0; e < 8; ++e) {
                        const float ye = y[e] * rn * gr[e >> 2][e & 3], yp = sx(ye, 32, lane);
                        constexpr float rp_[8] = {1.0f, 0.5623413251903491f, 0.31622776601683794f, 0.1778279410038923f, 0.1f, 0.05623413251903491f, 0.03162277660168379f, 0.01778279410038923f};
                        const float ang = posf * (inv0 * rp_[e]);
                        const double rr = (double)ang - 6.283185307179586 * rint((double)ang * 0.15915494309189535);
                        const float c = __cosf((float)rr), sn = __sinf((float)rr);
                        o[e] = fq < 2 ? ye * c - yp * sn : yp * sn + ye * c; }
                    u32x4 w; w.x = pk2(o[0], o[1]); w.y = pk2(o[2], o[3]); w.z = pk2(o[4], o[5]); w.w = pk2(o[6], o[7]);
                    *(u32x4*)(krow + 64 + 8 * fq) = w; }
        }
    }
};
struct EpiBf16 {
    static constexpr bool MIDK = false;
    bf16_t* O; int ldc; const float* ssq;
    __device__ __forceinline__ void operator()(f32x4 (&acc)[2][2][4][2], const Unit& u, int wr, int wc, int fr, int fq) const {
        const int row0 = u.pm * BM + wr * 64 + fr, col0 = u.pn * BM + wc * 32 + 8 * fq;
#pragma unroll
        for (int ai = 0; ai < 2; ++ai)
#pragma unroll
            for (int m = 0; m < 4; ++m) { const int row = row0 + ai * HALF + m * 16; bf16_t* rowp = O + (size_t)row * ldc + col0;
                const float rs = ssq ? 1.f / sqrtf(sum4(ssq + 4 * (size_t)row) * (1.f / DM) + EPS) : 1.f;
#pragma unroll
                for (int bj = 0; bj < 2; ++bj) { const f32x4 v0 = acc[ai][bj][m][0] * rs, v1 = acc[ai][bj][m][1] * rs;
                    u32x4 w; w.x = pk2(v0[0], v0[1]); w.y = pk2(v0[2], v0[3]); w.z = pk2(v1[0], v1[1]); w.w = pk2(v1[2], v1[3]);
                    *(u32x4*)(rowp + bj * HALF) = w; } }
    }
};
template <bool GN> struct EpiResid {
    static constexpr bool MIDK = GN;
    const bf16_t* xin; float* xout; bf16_t* xb; float* ssq; const float* gss; int f32out; LAS float* xch;
    __device__ __forceinline__ void mid(f32x4 (&acc)[2][2][4][2], const Unit& u, int wr, int fr) const {
#pragma unroll
        for (int ai = 0; ai < 2; ++ai)
#pragma unroll
            for (int m = 0; m < 4; ++m) { const int row = u.pm * BM + ai * HALF + wr * 64 + m * 16 + fr;
                const float* gp = gss + 16 * (size_t)row; const float ra = 1.f / sqrtf((sum4(gp) + sum4(gp + 4)) * (1.f / 512.f) + EPS), rb = 1.f / sqrtf((sum4(gp + 8) + sum4(gp + 12)) * (1.f / 512.f) + EPS), q = ra / rb;
#pragma unroll
                for (int bj = 0; bj < 2; ++bj) { acc[ai][bj][m][0] *= q; acc[ai][bj][m][1] *= q; } }
    }
    __device__ __forceinline__ void operator()(f32x4 (&acc)[2][2][4][2], const Unit& u, int wr, int wc, int fr, int fq) const {
        const int row0 = u.pm * BM + wr * 64 + fr, col0 = u.pn * BM + wc * 32 + 8 * fq, lane = fq * 16 + fr;
#pragma unroll
        for (int ai = 0; ai < 2; ++ai) {
            u32x4 pre[4][2];
#pragma unroll
            for (int m = 0; m < 4; ++m) { const size_t off = (size_t)(row0 + ai * HALF + m * 16) * DM + col0;
#pragma unroll
                for (int bj = 0; bj < 2; ++bj) pre[m][bj] = *(const u32x4*)(xin + off + bj * HALF); }
            asm volatile("" ::: "memory");
#pragma unroll
            for (int m = 0; m < 4; ++m) { const int row = row0 + ai * HALF + m * 16; const size_t off = (size_t)row * DM + col0;
                const float rb = GN ? 1.f / sqrtf((sum4(gss + 16 * (size_t)row + 8) + sum4(gss + 16 * (size_t)row + 12)) * (1.f / 512.f) + EPS) : 1.f;
                float ss = 0.f;
#pragma unroll
                for (int bj = 0; bj < 2; ++bj) {
                    const u32x4 p = pre[m][bj];
                    const f32x4 a = (f32x4){bflo(p.x), bfhi(p.x), bflo(p.y), bfhi(p.y)} + acc[ai][bj][m][0] * rb, b = (f32x4){bflo(p.z), bfhi(p.z), bflo(p.w), bfhi(p.w)} + acc[ai][bj][m][1] * rb;
                    if (f32out) { *(f32x4*)(xout + off + bj * HALF) = a; *(f32x4*)(xout + off + bj * HALF + 4) = b; }
                    else { u32x4 w; w.x = pk2(a[0], a[1]); w.y = pk2(a[2], a[3]); w.z = pk2(b[0], b[1]); w.w = pk2(b[2], b[3]);
                        *(u32x4*)(xb + off + bj * HALF) = w; }
                    ss += (a[0] * a[0] + a[1] * a[1]) + (a[2] * a[2] + a[3] * a[3]) + (b[0] * b[0] + b[1] * b[1]) + (b[2] * b[2] + b[3] * b[3]); }
                if (!f32out) { ss += sx(ss, 16, lane); ss += sx(ss, 32, lane);
                    if (fq == 0) xch[(ai * HALF + wr * 64 + m * 16 + fr) * 4 + wc] = ss; } }
        }
        if (!f32out) {
            asm volatile("s_waitcnt lgkmcnt(0)" ::: "memory"); __builtin_amdgcn_s_barrier(); asm volatile("" ::: "memory");
            const int tl = (wr * 4 + wc) * 64 + lane;
            if (tl < 256) { const f32x4 v = *(const LAS f32x4*)(xch + tl * 4); ssq[4 * (size_t)(u.pm * BM + tl) + u.pn] = ((v.x + v.y) + v.z) + v.w; }
        }
    }
};
__device__ __forceinline__ float dpp_ror1(float v) { return __builtin_bit_cast(float, __builtin_amdgcn_update_dpp(0, __builtin_bit_cast(int, v), 0x121, 0xf, 0xf, false)); }
typedef _Float16 h2_t __attribute__((ext_vector_type(2)));
__device__ __forceinline__ int dppi_ror1(int v) { return __builtin_amdgcn_update_dpp(0, v, 0x121, 0xf, 0xf, false); }
__device__ __forceinline__ int dppi_ror2(int v) { return __builtin_amdgcn_update_dpp(0, v, 0x122, 0xf, 0xf, false); }
__device__ __forceinline__ int dppi_shr1(int oldv, int v) { return __builtin_amdgcn_update_dpp(oldv, v, 0x111, 0xf, 0xf, false); }
__device__ __forceinline__ int dppi_shr2(int oldv, int v) { return __builtin_amdgcn_update_dpp(oldv, v, 0x112, 0xf, 0xf, false); }
__device__ __forceinline__ int pkh(float a, float b) { return __builtin_bit_cast(int, __builtin_amdgcn_cvt_pkrtz(a, b)); }
__device__ __forceinline__ float dpp_shr1(float oldv, float v) { return __builtin_bit_cast(float, __builtin_amdgcn_update_dpp(__builtin_bit_cast(int, oldv), __builtin_bit_cast(int, v), 0x111, 0xf, 0xf, false)); }
__device__ __forceinline__ float dpp_shr2(float oldv, float v) { return __builtin_bit_cast(float, __builtin_amdgcn_update_dpp(__builtin_bit_cast(int, oldv), __builtin_bit_cast(int, v), 0x112, 0xf, 0xf, false)); }
__device__ __forceinline__ float dpp_ror2(float v) { return __builtin_bit_cast(float, __builtin_amdgcn_update_dpp(0, __builtin_bit_cast(int, v), 0x122, 0xf, 0xf, false)); }
struct EpiConvGlu {
    static constexpr bool MIDK = false;
    bf16_t* act; const float* cw; const float* cb; LAS float* xch; const float* ssq; float* u4;
    __device__ __forceinline__ void operator()(f32x4 (&acc)[2][2][4][2], const Unit& u, int wr, int wc, int fr, int fq) const {
        const int colw = wc * 32 + 8 * fq;
#pragma unroll
        for (int ai = 0; ai < 2; ++ai)
#pragma unroll
            for (int m = 0; m < 4; ++m) { const int t = u.pm * 256 + ai * HALF + wr * 64 + m * 16 + fr;
                const float rs = 1.f / sqrtf(sum4(ssq + 4 * (size_t)t) * (1.f / DM) + EPS);
#pragma unroll
                for (int bj = 0; bj < 2; ++bj) { acc[ai][bj][m][0] *= rs; acc[ai][bj][m][1] *= rs; } }
        if (wr == 0 && fr < 2) {
#pragma unroll
            for (int bj = 0; bj < 2; ++bj)
#pragma unroll
                for (int n = 0; n < 2; ++n) *(f32x4*)(u4 + ((size_t)u.pm * 4 + fr) * (2 * DFF) + u.pn * 256 + bj * 128 + colw + 4 * n) = acc[0][bj][0][n];
        }
        if (wr == 1 && fr >= 14) {
#pragma unroll
            for (int bj = 0; bj < 2; ++bj)
#pragma unroll
                for (int n = 0; n < 2; ++n) *(f32x4*)(u4 + ((size_t)u.pm * 4 + 2 + (fr - 14)) * (2 * DFF) + u.pn * 256 + bj * 128 + colw + 4 * n) = acc[1][bj][3][n];
        }
        if (fr >= 14) {
#pragma unroll
            for (int ai = 0; ai < 2; ++ai)
#pragma unroll
                for (int bj = 0; bj < 2; ++bj)
#pragma unroll
                    for (int n = 0; n < 2; ++n) *(LAS f32x4*)(xch + ((ai * 2 + wr) * 2 + (fr - 14)) * 256 + bj * 128 + colw + 4 * n) = acc[ai][bj][3][n];
        }
        asm volatile("s_waitcnt lgkmcnt(0)" ::: "memory"); __builtin_amdgcn_s_barrier(); asm volatile("" ::: "memory");
        const int tbase = u.pm * 256;
        const bool seq_start = (u.pm & 15) == 0;
#pragma unroll
        for (int n = 0; n < 2; ++n) {
            const int ch = u.pn * 128 + colw + 4 * n;
            h2_t W0[4], W1[4], W2[4], Bb[4];
            { const f32x4 wg0 = *(const f32x4*)(cw + ch), wg1 = *(const f32x4*)(cw + 2 * DFF + ch), wg2 = *(const f32x4*)(cw + 4 * DFF + ch), bg = *(const f32x4*)(cb + ch);
              const f32x4 wv0 = *(const f32x4*)(cw + DFF + ch), wv1 = *(const f32x4*)(cw + 3 * DFF + ch), wv2 = *(const f32x4*)(cw + 5 * DFF + ch), bv = *(const f32x4*)(cb + DFF + ch);
#pragma unroll
              for (int j = 0; j < 4; ++j) { W0[j] = __builtin_bit_cast(h2_t, pkh(wg0[j], wv0[j])); W1[j] = __builtin_bit_cast(h2_t, pkh(wg1[j], wv1[j]));
                  W2[j] = __builtin_bit_cast(h2_t, pkh(wg2[j], wv2[j])); Bb[j] = __builtin_bit_cast(h2_t, pkh(bg[j], bv[j])); } }
#pragma unroll
            for (int ai = 0; ai < 2; ++ai) {
                const int strip = ai * 2 + wr;
                int X1[4] = {0, 0, 0, 0}, X2[4] = {0, 0, 0, 0};
                if (strip > 0 && fr < 2) {
                    const LAS float* xp = xch + ((strip - 1) * 2) * 256 + colw + 4 * n;
                    const f32x4 xg1 = *(const LAS f32x4*)(xp + 256), xv1 = *(const LAS f32x4*)(xp + 256 + 128);
                    const f32x4 xg2 = *(const LAS f32x4*)(xp + fr * 256), xv2 = *(const LAS f32x4*)(xp + fr * 256 + 128);
#pragma unroll
                    for (int j = 0; j < 4; ++j) { X1[j] = pkh(xg1[j], xv1[j]); X2[j] = pkh(xg2[j], xv2[j]); }
                }
                int Pp[4] = {0, 0, 0, 0};
#pragma unroll
                for (int m = 0; m < 4; ++m) {
                    const int lr = ai * HALF + wr * 64 + m * 16 + fr, t = tbase + lr, sp = t & (S - 1);
                    const int t0u = tbase + ai * HALF + wr * 64 + m * 16;
                    const bool has_start = ((t0u + 15) & (S - 1)) < 17;
                    float o[4];
#pragma unroll
                    for (int j = 0; j < 4; ++j) {
                        const int pc = pkh(acc[ai][0][m][n][j], acc[ai][1][m][n][j]);
                        const int o1_ = (m == 0) ? X1[j] : dppi_ror1(Pp[j]), o2_ = (m == 0) ? X2[j] : dppi_ror2(Pp[j]);
                        int s1 = dppi_shr1(o1_, pc), s2 = dppi_shr2(o2_, pc);
                        if (has_start) { s1 = sp >= 1 ? s1 : 0; s2 = sp >= 2 ? s2 : 0; }
                        const h2_t r = W2[j] * __builtin_bit_cast(h2_t, pc) + (W1[j] * __builtin_bit_cast(h2_t, s1) + (W0[j] * __builtin_bit_cast(h2_t, s2) + Bb[j]));
                        const float gg = (float)r.x, vv = (float)r.y;
                        o[j] = gg * __builtin_amdgcn_rcpf(1.f + __builtin_amdgcn_exp2f(-1.44269504f * gg)) * vv;
                        Pp[j] = pc;
                    }
                    if (lr >= 2 || seq_start) { u32x2 w; w.x = pk2(o[0], o[1]); w.y = pk2(o[2], o[3]); *(u32x2*)(act + (size_t)t * DFF + ch) = w; }
                }
            }
        }
    }
};
}

__device__ __forceinline__ s16x4 vtr(const LAS unsigned char* p) { typedef short v4i16 __attribute__((ext_vector_type(4))); return __builtin_bit_cast(s16x4, __builtin_amdgcn_ds_read_tr16_b64_v4i16((LAS v4i16*)p)); }

template <int DQK, bool CA, bool FIXM>
__device__ __forceinline__ void attn_tile(const LAS unsigned char* kb_, const LAS unsigned char* vb_, const bf16x8 (&qf)[DQK / 16], f32x16& o0, f32x16& o1, float& mrun, f32x16& osum,
                                          const LAS float* tab, int dl, int qi, int h, float cscale, const f32x16& cinit) {
    constexpr int KP = DQK * 2 + 16, NS = DQK / 16;
    f32x16 s0, s1;
    if (!FIXM) {
#pragma unroll
        for (int r = 0; r < 16; ++r) { s0[r] = 0.f; s1[r] = 0.f; }
    }
#pragma unroll
    for (int s = 0; s < NS; ++s) {
        const bf16x8 a0 = *(const LAS bf16x8*)(kb_ + s * 32), a1 = *(const LAS bf16x8*)(kb_ + 32 * KP + s * 32);
        s0 = __builtin_amdgcn_mfma_f32_32x32x16_bf16(a0, qf[s], (FIXM && s == 0) ? cinit : s0, 0, 0, 0);
        s1 = __builtin_amdgcn_mfma_f32_32x32x16_bf16(a1, qf[s], (FIXM && s == 0) ? cinit : s1, 0, 0, 0);
    }
    if (CA && FIXM) {
        if (dl < 3) {
#pragma unroll
            for (int r = 0; r < 16; ++r) { const int kj = (r & 3) + 8 * (r >> 2) + 4 * h; const int d0 = 64 * dl + qi - kj, d1 = d0 - 32;
                s0[r] += tab[(d0 < 128 ? d0 : 128) + 128]; s1[r] += tab[(d1 < 128 ? d1 : 128) + 128]; } }
    }
    if (CA && !FIXM) {
        if (dl >= 3) { const float bc = tab[256];
#pragma unroll
            for (int r = 0; r < 16; ++r) { s0[r] = s0[r] * cscale + bc; s1[r] = s1[r] * cscale + bc; } }
        else {
#pragma unroll
            for (int r = 0; r < 16; ++r) { const int kj = (r & 3) + 8 * (r >> 2) + 4 * h; const int d0 = 64 * dl + qi - kj, d1 = d0 - 32;
                s0[r] = s0[r] * cscale + tab[(d0 < 128 ? d0 : 128) + 128]; s1[r] = s1[r] * cscale + tab[(d1 < 128 ? d1 : 128) + 128]; } }
    }
    if (!FIXM) {
        float mx = s0[0];
#pragma unroll
        for (int r = 1; r < 16; ++r) mx = fmaxf(mx, s0[r]);
#pragma unroll
        for (int r = 0; r < 16; ++r) mx = fmaxf(mx, s1[r]);
        if (!CA) mx *= cscale;
        { float ua = mx, ub = mx; asm volatile("s_nop 1\n\tv_permlane32_swap_b32 %0, %1" : "+v"(ua), "+v"(ub));
          mx = fmaxf(ua, ub); }
        const float mnew = fmaxf(mrun, mx);
        if (__builtin_amdgcn_ballot_w64(mnew > mrun) != 0ull) {
            const float alpha = __builtin_amdgcn_exp2f(mrun - mnew);
            osum[0] *= alpha;
#pragma unroll
            for (int r = 0; r < 16; ++r) { o0[r] *= alpha; o1[r] *= alpha; }
            mrun = mnew;
        }
    }
    const bf16x8 ones = {16256, 16256, 16256, 16256, 16256, 16256, 16256, 16256};
#pragma unroll
    for (int kb = 0; kb < 2; ++kb) {
        f32x16& sk = kb == 0 ? s0 : s1;
#pragma unroll
        for (int r = 0; r < 16; ++r) sk[r] = FIXM ? __builtin_amdgcn_exp2f(sk[r]) : (CA ? __builtin_amdgcn_exp2f(sk[r] - mrun) : __builtin_amdgcn_exp2f(__builtin_fmaf(sk[r], cscale, -mrun)));
        bf16x8 pf[2];
#pragma unroll
        for (int s2 = 0; s2 < 2; ++s2) {
            u32x4 a;
            a.x = pk2a(sk[8 * s2 + 0], sk[8 * s2 + 1]); a.y = pk2a(sk[8 * s2 + 2], sk[8 * s2 + 3]); a.z = pk2a(sk[8 * s2 + 4], sk[8 * s2 + 5]); a.w = pk2a(sk[8 * s2 + 6], sk[8 * s2 + 7]);
            pf[s2] = __builtin_bit_cast(bf16x8, a);
        }
#pragma unroll
        for (int s2 = 0; s2 < 2; ++s2) {
            const int ro = (32 * kb + 16 * s2) * 64;
            const s16x4 x0 = vtr(vb_ + ro), x1 = vtr(vb_ + ro + 8 * 64), y0 = vtr(vb_ + 4096 + ro), y1 = vtr(vb_ + 4096 + ro + 8 * 64);
            const bf16x8 va = {x0[0], x0[1], x0[2], x0[3], x1[0], x1[1], x1[2], x1[3]};
            const bf16x8 vb2 = {y0[0], y0[1], y0[2], y0[3], y1[0], y1[1], y1[2], y1[3]};
            o0 = __builtin_amdgcn_mfma_f32_32x32x16_bf16(va, pf[s2], o0, 0, 0, 0);
            o1 = __builtin_amdgcn_mfma_f32_32x32x16_bf16(vb2, pf[s2], o1, 0, 0, 0);
            osum = __builtin_amdgcn_mfma_f32_32x32x16_bf16(ones, pf[s2], osum, 0, 0, 0);
        }
    }
}

template <int DQK, bool CA, bool FIXM>
__device__ __forceinline__ void attn_unit(LAS unsigned char* lds, const bf16_t* Qh, int qp, const bf16_t* Kh, int kp, const bf16_t* Vh, int vp, bf16_t* Oh,
                                          int tile_lo, int tile_hi, int q0, const float* bias, float cscale, float* gss,
                                          const bf16_t* cqrow0, const float* gqn, const int* posrow0, float mfix, int wid0) {
    constexpr int NCH = DQK / 8, KP = DQK * 2 + 16, KBUF = 64 * KP, BUF = KBUF + 8192, NS = DQK / 16;
    constexpr int TAB_OFF = 2 * BUF;
    int tid = tid_of(wid0);
    const int w = wid0, lane = tid & 63, h = lane >> 5, l31 = lane & 31;
    const int cq = (q0 >> 6) + (w >> 1);
    LAS float* tab = (LAS float*)(lds + TAB_OFF);
    if (CA) { if (tid < 257) tab[tid] = (bias[tid] - (FIXM ? bias[256] : 0.f)) * 1.44269504f; }
    u32x4 kA0, kA1 = {0, 0, 0, 0}, vA, kB0, kB1 = {0, 0, 0, 0}, vB;
    const int vrow = tid >> 3, vch = tid & 7;
    const int krow0 = tid / NCH, kch0 = tid % NCH, krow1 = (tid + 512) / NCH, kch1 = (tid + 512) % NCH;
    const bf16_t* vsrc = Vh + (size_t)vrow * vp + vch * 8; const bf16_t* ksrc0 = Kh + (size_t)krow0 * kp + kch0 * 8; const bf16_t* ksrc1 = (tid < 256) ? Kh + (size_t)krow1 * kp + kch1 * 8 : ksrc0;
    const int kdst0 = krow0 * KP + kch0 * 16, kdst1 = krow1 * KP + kch1 * 16, vdst = KBUF + (vch >> 2) * 4096 + vrow * 64 + (vch & 3) * 16;
#define AT_GLOAD(K0, K1, V, tile) do { const int tl_ = (tile) < tile_hi ? (tile) : tile_hi; const size_t k0_ = (size_t)tl_ * 64; V = *(const u32x4*)(vsrc + k0_ * vp); K0 = *(const u32x4*)(ksrc0 + k0_ * kp); \
        if (NCH == 12) K1 = *(const u32x4*)(ksrc1 + k0_ * kp); } while (0)
#define AT_LSTORE(K0, K1, V, buf) do { LAS unsigned char* b_ = lds + (buf) * BUF; *(LAS u32x4*)(b_ + kdst0) = K0; if (NCH == 12 && tid < 256) *(LAS u32x4*)(b_ + kdst1) = K1; \
        *(LAS u32x4*)(b_ + vdst) = V; } while (0)
#define AT_BAR() do { asm volatile("s_waitcnt lgkmcnt(0)" ::: "memory"); __builtin_amdgcn_s_barrier(); asm volatile("" ::: "memory"); } while (0)
    AT_GLOAD(kA0, kA1, vA, tile_lo);
    bf16x8 qf[NS];
    { const bf16_t* qrow = Qh + (size_t)(q0 + 32 * w + l31) * qp + 8 * h;
#pragma unroll
      for (int s = 0; s < NS; ++s) qf[s] = *(const bf16x8*)(qrow + 16 * s); }
    if (!CA) {
        const int trow = q0 + 32 * w + l31;
        float ssc = 0.f;
        { const bf16_t* cq = cqrow0 + (size_t)trow * PW + 128 * h;
#pragma unroll
          for (int k = 0; k < 16; ++k) { const u32x4 a = *(const u32x4*)(cq + 8 * k);
              const float f0 = bflo(a.x), f1 = bfhi(a.x), f2 = bflo(a.y), f3 = bfhi(a.y), f4 = bflo(a.z), f5 = bfhi(a.z), f6 = bflo(a.w), f7 = bfhi(a.w);
              ssc += ((f0 * f0 + f1 * f1) + (f2 * f2 + f3 * f3)) + ((f4 * f4 + f5 * f5) + (f6 * f6 + f7 * f7)); } }
        { float ua = ssc, ub = ssc; asm volatile("s_nop 1\n\tv_permlane32_swap_b32 %0, %1" : "+v"(ua), "+v"(ub)); ssc = ua + ub; }
        const float rq = 1.f / sqrtf(ssc * (1.f / 256.f) + EPS);
        float z[NS][8]; float ssz = 0.f;
#pragma unroll
        for (int s = 0; s < NS; ++s) { const u32x4 a = __builtin_bit_cast(u32x4, qf[s]);
            z[s][0] = bflo(a.x) * rq; z[s][1] = bfhi(a.x) * rq; z[s][2] = bflo(a.y) * rq; z[s][3] = bfhi(a.y) * rq; z[s][4] = bflo(a.z) * rq; z[s][5] = bfhi(a.z) * rq; z[s][6] = bflo(a.w) * rq; z[s][7] = bfhi(a.w) * rq;
#pragma unroll
            for (int e = 0; e < 8; ++e) ssz += z[s][e] * z[s][e]; }
        { float ua = ssz, ub = ssz; asm volatile("s_nop 1\n\tv_permlane32_swap_b32 %0, %1" : "+v"(ua), "+v"(ub)); ssz = ua + ub; }
        const float rn = (1.f / sqrtf(ssz * (1.f / 96.f) + EPS)) * (FIXM ? cscale : 1.f);
#pragma unroll
        for (int s = 0; s < NS; ++s) { const f32x4 g0 = *(const f32x4*)(gqn + 16 * s + 8 * h), g1 = *(const f32x4*)(gqn + 16 * s + 8 * h + 4);
#pragma unroll
            for (int e = 0; e < 4; ++e) { z[s][e] *= rn * g0[e]; z[s][4 + e] *= rn * g1[e]; } }
        const float pos = (float)posrow0[trow];
#pragma unroll
        for (int e = 0; e < 8; ++e) {
            const float inv = exp2f(-(float)(8 * h + e) * (13.287712379549449f / 16.f)), ang = pos * inv;
            const double rr = (double)ang - 6.283185307179586 * rint((double)ang * 0.15915494309189535);
            const float c = __cosf((float)rr), sn = __sinf((float)rr), a = z[4][e], b = z[5][e];
            z[4][e] = a * c - b * sn; z[5][e] = a * sn + b * c; }
#pragma unroll
        for (int s = 0; s < NS; ++s) { u32x4 a; a.x = pk2a(z[s][0], z[s][1]); a.y = pk2a(z[s][2], z[s][3]); a.z = pk2a(z[s][4], z[s][5]); a.w = pk2a(z[s][6], z[s][7]); qf[s] = __builtin_bit_cast(bf16x8, a); }
    }
    if (CA && FIXM) {
#pragma unroll
        for (int s = 0; s < NS; ++s) { const u32x4 a = __builtin_bit_cast(u32x4, qf[s]); u32x4 b;
            b.x = pk2a(bflo(a.x) * cscale, bfhi(a.x) * cscale); b.y = pk2a(bflo(a.y) * cscale, bfhi(a.y) * cscale); b.z = pk2a(bflo(a.z) * cscale, bfhi(a.z) * cscale); b.w = pk2a(bflo(a.w) * cscale, bfhi(a.w) * cscale);
            qf[s] = __builtin_bit_cast(bf16x8, b); }
    }
    f32x16 cinit;
    { const float cv = FIXM ? (CA ? bias[256] * 1.44269504f - mfix : -mfix) : 0.f;
#pragma unroll
      for (int r = 0; r < 16; ++r) cinit[r] = cv; }
    f32x16 o0, o1;
#pragma unroll
    for (int r = 0; r < 16; ++r) { o0[r] = 0.f; o1[r] = 0.f; }
    float mrun = FIXM ? 0.f : -1e30f; f32x16 osum;
#pragma unroll
    for (int r = 0; r < 16; ++r) osum[r] = 0.f;
    AT_LSTORE(kA0, kA1, vA, 0);
    AT_GLOAD(kA0, kA1, vA, tile_lo + 1);
    if (w >= 4) __builtin_amdgcn_s_setprio(1);
    AT_BAR();
    const int koff = l31 * KP + h * 16;
    const int voff = KBUF + (4 * h + ((lane & 15) >> 2)) * 64 + (((lane >> 4) & 1) * 16 + (lane & 3) * 4) * 2;
    const int qi = 32 * (w & 1) + l31;
#define AT_BODY(tile, L0, L1, LV, S0, S1, SV, buf) do { \
        AT_GLOAD(L0, L1, LV, (tile) + 2); \
        const bool active_ = CA ? ((tile) >= cq - 8 && (tile) <= cq) : ((tile) <= cq); \
        if (active_) attn_tile<DQK, CA, FIXM>(lds + (buf) * BUF + koff, lds + (buf) * BUF + voff, qf, o0, o1, mrun, osum, tab, cq - (tile), qi, h, cscale, cinit); \
        if ((tile) + 1 <= tile_hi) AT_LSTORE(S0, S1, SV, (buf) ^ 1); \
        AT_BAR(); } while (0)
    for (int tile = tile_lo; tile <= tile_hi; tile += 2) {
        AT_BODY(tile, kB0, kB1, vB, kA0, kA1, vA, 0);
        if (tile + 1 <= tile_hi) AT_BODY(tile + 1, kA0, kA1, vA, kB0, kB1, vB, 1);
    }
    __builtin_amdgcn_s_setprio(0);
    const float inv = 1.f / osum[0];
    { float ss = 0.f;
#pragma unroll
      for (int r = 0; r < 16; ++r) { const float a = o0[r] * inv, b = o1[r] * inv; ss += a * a + b * b; }
      float ua = ss, ub = ss; asm volatile("s_nop 1\n\tv_permlane32_swap_b32 %0, %1" : "+v"(ua), "+v"(ub));
      if (h == 0) gss[16 * (size_t)(q0 + 32 * w + l31)] = ua + ub; }
    bf16_t* orow = Oh + (size_t)(q0 + 32 * w + l31) * DM + 4 * h;
#pragma unroll
    for (int i4 = 0; i4 < 4; ++i4) {
        u32x2 a, b;
        a.x = pk2a(o0[4 * i4] * inv, o0[4 * i4 + 1] * inv); a.y = pk2a(o0[4 * i4 + 2] * inv, o0[4 * i4 + 3] * inv);
        b.x = pk2a(o1[4 * i4] * inv, o1[4 * i4 + 1] * inv); b.y = pk2a(o1[4 * i4 + 2] * inv, o1[4 * i4 + 3] * inv);
        *(u32x2*)(orow + 8 * i4) = a; *(u32x2*)(orow + 32 + 8 * i4) = b;
    }
#undef AT_GLOAD
#undef AT_LSTORE
#undef AT_BAR
#undef AT_BODY
}

#define XB_TMO      128
#define XB_XCNT(j)  (256  + 64 * (j))
#define XB_XSUB(j)  (1280 + 64 * (j))
#define XB_XGEN(j)  (2304 + 64 * (j))
#define XB_TOP      3328
#define XB_TOPGEN   3392
#define XCD_BAR_WORDS 3456
#define XB_SPIN_CAP (1u << 18)

__device__ __forceinline__ unsigned xb_ld(unsigned* p)              { return __hip_atomic_load(p, __ATOMIC_RELAXED, __HIP_MEMORY_SCOPE_AGENT); }
__device__ __forceinline__ unsigned xb_add(unsigned* p, unsigned v) { return __hip_atomic_fetch_add(p, v, __ATOMIC_RELAXED, __HIP_MEMORY_SCOPE_AGENT); }
__device__ __forceinline__ unsigned xb_xcc_id() { return (unsigned)__builtin_amdgcn_s_getreg((3 << 11) | 20) & 0xFu; }
#define XB_SPIN(cond, bar) do { unsigned _sp = 0; while (cond) { __builtin_amdgcn_s_sleep(1); \
    if ((++_sp & 255u) == 0u) { if (xb_ld(&(bar)[XB_TMO])) break; if (_sp > XB_SPIN_CAP) { atomicAdd(&(bar)[XB_TMO], 1u); break; } } } } while (0)

struct XcdBarrier {
    unsigned* bar; unsigned x;
    volatile LAS unsigned* st;
};

__device__ __forceinline__ XcdBarrier xcd_barrier_post(unsigned* bar, volatile LAS unsigned* st) {
    XcdBarrier b; b.bar = bar; b.x = xb_xcc_id(); b.st = st;
    if (threadIdx.x == 0) (void)xb_add(&bar[XB_XCNT(b.x)], 1u);
    return b;
}
__device__ __forceinline__ void xcd_barrier_complete(unsigned* bar, unsigned x, unsigned& nloc, unsigned& nx) {
    const unsigned G = gridDim.x * gridDim.y * gridDim.z;
    unsigned sum, cnt, mine, sp = 0u;
    for (;;) {
        sum = 0u; cnt = 0u; mine = 0u;
#pragma unroll
        for (unsigned j = 0; j < 16; ++j) { const unsigned c = xb_ld(&bar[XB_XCNT(j)]); sum += c; cnt += (c > 0u) ? 1u : 0u; mine = (j == x) ? c : mine; }
        if (sum == G) break;
        __builtin_amdgcn_s_sleep(1);
        if ((++sp & 255u) == 0u) { if (xb_ld(&bar[XB_TMO])) break; if (sp > XB_SPIN_CAP) { atomicAdd(&bar[XB_TMO], 1u); break; } }
    }
    nloc = mine > 0u ? mine : 1u; nx = cnt > 0u ? cnt : 1u;
}

__device__ __forceinline__ void xcd_barrier(const XcdBarrier& b) {
    asm volatile("s_waitcnt vmcnt(0)" ::: "memory");
    __syncthreads();
    if (threadIdx.x == 0) {
        unsigned* bar = b.bar;
        __builtin_amdgcn_s_waitcnt(0);
        unsigned nloc = b.st[0], nx = b.st[1];
        if (nloc == 0u) { xcd_barrier_complete(bar, b.x, nloc, nx); b.st[0] = nloc; b.st[1] = nx; }
        const unsigned old = xb_add(&bar[XB_XSUB(b.x)], 1u);
        const unsigned gen = old / nloc;
        if (old + 1u == (gen + 1u) * nloc) {
            __builtin_amdgcn_fence(__ATOMIC_RELEASE, "agent");
            asm volatile("s_waitcnt vmcnt(0)" ::: "memory");
            const unsigned og = xb_add(&bar[XB_TOP], 1u);
            const unsigned tg = og / nx;
            if (og + 1u == (tg + 1u) * nx) xb_add(&bar[XB_TOPGEN], 1u);
            else XB_SPIN(xb_ld(&bar[XB_TOPGEN]) == tg, bar);
            __builtin_amdgcn_fence(__ATOMIC_ACQUIRE, "agent");
            xb_add(&bar[XB_XGEN(b.x)], 1u);
            asm volatile("s_waitcnt vmcnt(0)" ::: "memory");
        } else {
            XB_SPIN(xb_ld(&bar[XB_XGEN(b.x)]) == gen, bar);
            __builtin_amdgcn_fence(__ATOMIC_ACQUIRE, "agent");
            asm volatile("s_waitcnt vmcnt(0)" ::: "memory");
        }
    }
    __syncthreads();
}

struct Args { const void* in[21]; float* out; unsigned char* ws; int ph_lo, ph_hi; };


__device__ __forceinline__ const void* karg(int i) {
    const __attribute__((address_space(4))) char* kp = (const __attribute__((address_space(4))) char*)__builtin_amdgcn_kernarg_segment_ptr();
    unsigned off = (unsigned)i * 8u; asm volatile("" : "+s"(off));
    return *(const void* const __attribute__((address_space(4)))*)(kp + off);
}

__device__ __forceinline__ float wave_sum_(float v, int lane) {
#pragma unroll
    for (int o = 1; o < 64; o <<= 1) v += sx(v, o, lane);
    return v;
}

__device__ __forceinline__ void transpose_item(const float* W, int K, int Nsrc, bf16_t* WT, const float* g0, const float* g1, int mode, int Nd, LAS float* scr, int item, int lane) {
    const int nblk = Nd / 32, kb = item / nblk, nb = item % nblk, k0 = 64 * kb, n0 = 32 * nb;
    int src;
    if (mode == 0) src = n0 < Nsrc ? n0 : -1;
    else if (mode == 4) { const int tq = n0 >> 8, p = n0 & 255, bj = p >> 7, wc = (p >> 5) & 3; src = (2 * tq + (wc & 1)) * 128 + (wc >> 1) * 64 + 32 * bj; }
    else if (mode == 3) {
        if (n0 < 416) src = n0; else if (n0 < 512) src = -1;
        else if (n0 < 1536) { const int tq = (n0 - 512) >> 8, p = (n0 - 512) & 255, bj = p >> 7, wc = (p >> 5) & 3; src = 416 + tq * 256 + wc * 64 + bj * 32; }
        else src = 416 + 1024 + (n0 - 1536);
    }
    else if (mode == 1) { const int hh = n0 / 128, d0 = n0 % 128; src = d0 < 96 ? hh * 96 + d0 : -1; }
    else { const int pn = n0 / 256, j0 = n0 % 256; src = j0 < 128 ? 128 * pn + j0 : DFF + 128 * pn + (j0 - 128); }
#pragma unroll
    for (int i = 0; i < 8; ++i) { const int kk = 8 * i + (lane >> 3), n4 = (lane & 7) * 4; const int k = k0 + kk;
        f32x4 v = {0.f, 0.f, 0.f, 0.f};
        if (src >= 0) { v = *(const f32x4*)(W + (size_t)k * Nsrc + src + n4); if (g0) v *= (g1 && k >= 512) ? g1[k - 512] : g0[k]; }
        scr[kk * 33 + n4] = v.x; scr[kk * 33 + n4 + 1] = v.y; scr[kk * 33 + n4 + 2] = v.z; scr[kk * 33 + n4 + 3] = v.w; }
    asm volatile("s_waitcnt lgkmcnt(0)" ::: "memory");
    const int c = lane & 7;
#pragma unroll
    for (int j = 0; j < 4; ++j) { const int n = (lane >> 3) + 8 * j; const LAS float* s = scr + (8 * c) * 33 + n;
        u32x4 o; o.x = pk2(s[0 * 33], s[1 * 33]); o.y = pk2(s[2 * 33], s[3 * 33]); o.z = pk2(s[4 * 33], s[5 * 33]); o.w = pk2(s[6 * 33], s[7 * 33]);
        *(u32x4*)(WT + (size_t)(n0 + n) * K + k0 + 8 * c) = o; }
    asm volatile("s_waitcnt lgkmcnt(0)" ::: "memory");
}

__global__ void __launch_bounds__(NTHR, 2) fwd_kernel(Args args) {
    extern __shared__ __attribute__((aligned(16))) unsigned char lds_raw[];
    LAS unsigned char* lds = (LAS unsigned char*)lds_raw;
    cg::grid_group grid = cg::this_grid();
    const int G = gridDim.x, bx = blockIdx.x, NGW = G * NWAVES;


    const int lo = args.ph_lo, hi = args.ph_hi;
    const int wid0 = __builtin_amdgcn_readfirstlane(threadIdx.x >> 6);
    { int t0 = threadIdx.x; if (t0 < 4) ((volatile LAS unsigned*)(lds + MISC_OFF))[t0] = 0u; }
    __syncthreads();
    XcdBarrier xbar = xcd_barrier_post((unsigned*)karg(22) + CW_BAR, (volatile LAS unsigned*)(lds + MISC_OFF));
    int ph = 0; int l_ = -1;
#define PHASE_BEGIN if (ph >= lo && ph < hi) { int tid = tid_of(wid0); const int lane = tid & 63, wave = wid0, gw = bx * NWAVES + wave; (void)lane; (void)gw; unsigned char* ws = (unsigned char*)karg(22); float* xo = (float*)karg(21); (void)xo; \
    bf16_t* HB = (bf16_t*)(ws + WS_HB); bf16_t* PB = (bf16_t*)(ws + WS_PB); bf16_t* QRAW = (bf16_t*)(ws + WS_QRAW); bf16_t* KVRAW = (bf16_t*)(ws + WS_KVRAW); bf16_t* KM = (bf16_t*)(ws + WS_KM); bf16_t* ACT = (bf16_t*)(ws + WS_ACT); \
    (void)HB; (void)PB; (void)QRAW; (void)KVRAW; (void)KM; (void)ACT; unsigned char* wl = ws + WS_W + (l_ < 0 ? 0 : l_) * W_LAYER; (void)wl; \
    const float* xsrc = (l_ <= 0) ? (const float*)karg(0) : (const float*)xo; (void)xsrc;
#define PHASE_END   if (ph + 1 < hi) { if (hi < 0) grid.sync(); else xcd_barrier(xbar);         } } ++ph;

    PHASE_BEGIN
    {
        LAS float* scr = (LAS float*)(lds + wave * 16384);
        constexpr int I_IN = 16 * 64, I_UQ = 4 * 24, I_UKV = 2 * 32, I_OUT = 16 * 32, I_UP = 16 * 176, I_DN = 44 * 32, I_L = I_IN + I_UQ + I_UKV + I_OUT + I_UP + I_DN;
        for (int it = gw; it < DEPTH * I_L; it += NGW) {
            const int l = it / I_L; int r = it % I_L;
            unsigned char* wl = ws + WS_W + l * W_LAYER;
            if (r < I_IN) { transpose_item((const float*)karg(3) + (size_t)l * DM * INC, DM, INC, (bf16_t*)(wl + WO_IN), (const float*)karg(2) + l * DM, nullptr, 3, PW, scr, r, lane); continue; } r -= I_IN;
            if (r < I_UQ) { transpose_item((const float*)karg(4) + (size_t)l * 256 * 768, 256, 768, (bf16_t*)(wl + WO_UQ), (const float*)karg(6) + l * 256, nullptr, 0, 768, scr, r, lane); continue; } r -= I_UQ;
            if (r < I_UKV) { transpose_item((const float*)karg(5) + (size_t)l * 128 * 1024, 128, 1024, (bf16_t*)(wl + WO_UKV), (const float*)karg(7) + l * 128, nullptr, 4, 1024, scr, r, lane); continue; } r -= I_UKV;
            if (r < I_OUT) { transpose_item((const float*)karg(15) + (size_t)l * DM * DM, DM, DM, (bf16_t*)(wl + WO_OUT), (const float*)karg(13) + l * 512, (const float*)karg(14) + l * 512, 0, DM, scr, r, lane); continue; } r -= I_OUT;
            if (r < I_UP) { transpose_item((const float*)karg(17) + (size_t)l * DM * 2 * DFF, DM, 2 * DFF, (bf16_t*)(wl + WO_UP), (const float*)karg(16) + l * DM, nullptr, 2, 2 * DFF, scr, r, lane); continue; } r -= I_UP;
            transpose_item((const float*)karg(20) + (size_t)l * DFF * DM, DFF, DM, (bf16_t*)(wl + WO_DOWN), nullptr, nullptr, 0, DM, scr, r, lane);
        }
    }

        {
            float* ssq = (float*)(ws + WS_SSQ);
            const float* x0 = (const float*)karg(0);
            for (int m = gw; m < T; m += NGW) {
                const f32x4* xr = (const f32x4*)(x0 + (size_t)m * DM) + lane;
                f32x4 v[4]; float s = 0.f;
#pragma unroll
                for (int j = 0; j < 4; ++j) { v[j] = xr[64 * j]; s += (v[j].x * v[j].x + v[j].y * v[j].y) + (v[j].z * v[j].z + v[j].w * v[j].w); }
                s = wave_sum_(s, lane);
                u32x2* o8 = (u32x2*)((bf16_t*)xo + (size_t)m * DM) + lane;
#pragma unroll
                for (int j = 0; j < 4; ++j) { u32x2 w; w.x = pk2(v[j].x, v[j].y); w.y = pk2(v[j].z, v[j].w); o8[64 * j] = w; }
                if (lane == 0) *(f32x4*)(ssq + 4 * (size_t)m) = (f32x4){s, 0.f, 0.f, 0.f};
            }
        }
    PHASE_END

    for (int l = 0; l < DEPTH; ++l) {
        l_ = l;


        PHASE_BEGIN
        { pg8::Gemm g{(const bf16_t*)xo, (const bf16_t*)(wl + WO_IN), DM, DM, 256, 0}; pg8::StaticOrder So; So.init(T / 256, PW / 256, G, bx);
          pg8::EpiProj E{PB, (const float*)(ws + WS_SSQ), (const float*)karg(10) + l * 64, (const float*)karg(11) + l * 64, (float*)(ws + WS_RKV)}; pg8::gemm_phase(lds, g, So, E, wid0); }
        PHASE_END

        PHASE_BEGIN
        { pg8::Gemm g{PB, (const bf16_t*)(wl + WO_UQ), PW, 256, 256, 0}; pg8::StaticOrder So; So.init(T / 256, 3, G, bx);
          pg8::EpiBf16 E{QRAW, 1024, nullptr}; pg8::gemm_phase(lds, g, So, E, wid0); }
        { pg8::Gemm g{PB + OFF_CKV, (const bf16_t*)(wl + WO_UKV), PW, 128, 256, 0}; pg8::StaticOrder So; So.init(T / 256, 4, G, bx);
          pg8::EpiKV E{KM, KVRAW, PB, (const float*)(ws + WS_RKV), (const float*)karg(9) + l * 96, (const int*)karg(1)}; pg8::gemm_phase(lds, g, So, E, wid0); }
        PHASE_END


        PHASE_BEGIN
        {
            const float* relb = (const float*)karg(12) + (size_t)l * 8 * 257;
            float* gssb = (float*)(ws + WS_GSS);
            float bmla, bca;
            { const float* gq_ = (const float*)karg(8) + l * 96; const float* gk_ = (const float*)karg(9) + l * 96;
              const float* gcq_ = (const float*)karg(10) + l * 64; const float* gck_ = (const float*)karg(11) + l * 64;
              float a = fmaxf(fabsf(gq_[lane]), lane < 32 ? fabsf(gq_[64 + lane]) : 0.f), b = fmaxf(fabsf(gk_[lane]), lane < 32 ? fabsf(gk_[64 + lane]) : 0.f);
              float c = fabsf(gcq_[lane]), d = fabsf(gck_[lane]), e = -1e30f;
              for (int i = lane; i < 8 * 257; i += 64) e = fmaxf(e, relb[i]);
#pragma unroll
              for (int o = 1; o < 64; o <<= 1) { a = fmaxf(a, sx(a, o, lane)); b = fmaxf(b, sx(b, o, lane)); c = fmaxf(c, sx(c, o, lane)); d = fmaxf(d, sx(d, o, lane)); e = fmaxf(e, sx(e, o, lane)); }
              bmla = 96.f * a * b * (0.10206207261596575f * 1.44269504f) * 1.03f + 0.5f;
              bca = 64.f * c * d * (0.125f * 1.44269504f) * 1.03f + e * 1.44269504f + 0.5f; }
            bmla = __builtin_bit_cast(float, __builtin_amdgcn_readfirstlane(__builtin_bit_cast(int, bmla))); bca = __builtin_bit_cast(float, __builtin_amdgcn_readfirstlane(__builtin_bit_cast(int, bca)));
            const bool fixm = (bmla < 40.f) && (bca < 40.f) && (bca > -40.f);

            for (int i = 0;; ++i) {
                const int L = i * G + bx; if (L >= 2048) break;
                if (L < 1024) {
                    const int r = L >> 8, jj = L & 255, gq_ = jj >> 6, bh = jj & 63, b = bh >> 3, hh = bh & 7;
                    const int qb = (r & 1) ? (12 - 4 * r) + gq_ : (15 - 4 * r) - gq_;
                    const size_t rb = (size_t)b * S;
                    if (fixm) attn_unit<96, false, true>(lds, QRAW + rb * 1024 + hh * 96, 1024, KM + rb * 768 + hh * 96, 768, KVRAW + rb * 1024 + hh * 128 + 64, 1024, HB + rb * DM + hh * 64,
                                         0, 4 * qb + 3, qb * 256, nullptr, 0.10206207261596575f * 1.44269504f, gssb + 16 * rb + hh, PB + rb * PW, (const float*)karg(8) + l * 96, (const int*)karg(1) + rb, bmla, wid0);
                    else attn_unit<96, false, false>(lds, QRAW + rb * 1024 + hh * 96, 1024, KM + rb * 768 + hh * 96, 768, KVRAW + rb * 1024 + hh * 128 + 64, 1024, HB + rb * DM + hh * 64,
                                         0, 4 * qb + 3, qb * 256, nullptr, 0.10206207261596575f * 1.44269504f, gssb + 16 * rb + hh, PB + rb * PW, (const float*)karg(8) + l * 96, (const int*)karg(1) + rb, 0.f, wid0);
                } else {
                    const int v = L - 1024, bh = v & 63, cgp = v >> 6, b = bh >> 3, hh = bh & 7;
                    const size_t rb = (size_t)b * S;
                    const int tlo = 4 * cgp - 8 < 0 ? 0 : 4 * cgp - 8;
                    if (fixm) attn_unit<64, true, true>(lds, PB + rb * PW + OFF_CA + hh * 64, PW, PB + rb * PW + OFF_CA + 512 + hh * 64, PW, PB + rb * PW + OFF_CA + 1024 + hh * 64, PW, HB + rb * DM + 512 + hh * 64,
                                        tlo, 4 * cgp + 3, cgp * 256, relb + hh * 257, 0.125f * 1.44269504f, gssb + 16 * rb + 8 + hh, nullptr, nullptr, nullptr, bca, wid0);
                    else attn_unit<64, true, false>(lds, PB + rb * PW + OFF_CA + hh * 64, PW, PB + rb * PW + OFF_CA + 512 + hh * 64, PW, PB + rb * PW + OFF_CA + 1024 + hh * 64, PW, HB + rb * DM + 512 + hh * 64,
                                        tlo, 4 * cgp + 3, cgp * 256, relb + hh * 257, 0.125f * 1.44269504f, gssb + 16 * rb + 8 + hh, nullptr, nullptr, nullptr, 0.f, wid0);
                }
            }
        }
        PHASE_END


        PHASE_BEGIN
        { pg8::Gemm g{HB, (const bf16_t*)(wl + WO_OUT), DM, DM, 256, 0}; pg8::StaticOrder So; So.init(T / 256, 4, G, bx);
          pg8::EpiResid<true> E{(const bf16_t*)xo, nullptr, (bf16_t*)(ws + WS_HB2), (float*)(ws + WS_SSQ) + 4 * (size_t)T, (const float*)(ws + WS_GSS), 0, (LAS float*)(lds + XCH_OFF)}; pg8::gemm_phase(lds, g, So, E, wid0); }
        PHASE_END


        PHASE_BEGIN
        { pg8::Gemm g{(const bf16_t*)(ws + WS_HB2), (const bf16_t*)(wl + WO_UP), DM, DM, 256, 0}; pg8::StaticOrder So; So.init(T / 256, 22, G, bx);
          pg8::EpiConvGlu E{ACT, (const float*)karg(18) + (size_t)l * 3 * 2 * DFF, (const float*)karg(19) + (size_t)l * 2 * DFF, (LAS float*)(lds + XCH_OFF), (const float*)(ws + WS_SSQ) + 4 * (size_t)T, (float*)(ws + WS_U4)};
          pg8::gemm_phase(lds, g, So, E, wid0); }
        PHASE_END

        PHASE_BEGIN
        { pg8::Gemm g{ACT, (const bf16_t*)(wl + WO_DOWN), DFF, DFF, 256, 0}; pg8::StaticOrder So; So.init(T / 256, 4, G, bx);
          {
              const float* u4 = (const float*)(ws + WS_U4); const float* cw = (const float*)karg(18) + (size_t)l * 3 * 2 * DFF; const float* cb = (const float*)karg(19) + (size_t)l * 2 * DFF;
              pg8::Unit uu;
              for (int i = 0; So.next(i, uu); ++i) {
                  const int pm = uu.pm; if ((pm & 15) == 0) continue;
                  for (int idx = tid; idx < 2 * DFF; idx += NTHR) {
                      const int r = idx / DFF, ch = idx % DFF;
                      const int pc = (ch >> 7) * 256 + (ch & 127);
                      const float* cur = u4 + ((size_t)pm * 4) * (2 * DFF); const float* prv = u4 + ((size_t)(pm - 1) * 4) * (2 * DFF);
                      const float g0 = cur[(size_t)r * (2 * DFF) + pc], v0 = cur[(size_t)r * (2 * DFF) + pc + 128];
                      const float g1 = r == 0 ? prv[(size_t)3 * (2 * DFF) + pc] : cur[pc], v1 = r == 0 ? prv[(size_t)3 * (2 * DFF) + pc + 128] : cur[pc + 128];
                      const float g2 = prv[(size_t)(2 + r) * (2 * DFF) + pc], v2 = prv[(size_t)(2 + r) * (2 * DFF) + pc + 128];
                      const float gg = cw[4 * DFF + ch] * g0 + cw[2 * DFF + ch] * g1 + cw[ch] * g2 + cb[ch];
                      const float vv = cw[5 * DFF + ch] * v0 + cw[3 * DFF + ch] * v1 + cw[DFF + ch] * v2 + cb[DFF + ch];
                      const float o = gg * __builtin_amdgcn_rcpf(1.f + __builtin_amdgcn_exp2f(-1.44269504f * gg)) * vv;
                      ACT[(size_t)(256 * pm + r) * DFF + ch] = (bf16_t)f2bf(o);
                  }
              }
              asm volatile("s_waitcnt vmcnt(0)" ::: "memory"); __syncthreads();
          }
          pg8::EpiResid<false> E{(const bf16_t*)(ws + WS_HB2), xo, (bf16_t*)xo, (float*)(ws + WS_SSQ), nullptr, l == DEPTH - 1 ? 1 : 0, (LAS float*)(lds + XCH_OFF)}; pg8::gemm_phase(lds, g, So, E, wid0); }
        PHASE_END
    }
}

constexpr int N_PHASES = 1 + 6 * DEPTH;
#ifndef N_LAUNCH_SPLIT
#define N_LAUNCH_SPLIT 0
#endif

extern "C" void kernel_launch(void* const* d_in, const int* in_sizes, int n_in, void* d_out, int out_size, void* d_ws, size_t ws_size, hipStream_t stream) {
    static int grid = 0;
    if (grid == 0) {
        if (n_in != 21 || ws_size < WS_END) { fprintf(stderr, "kernel_launch: unexpected n_in %d / ws %zu\n", n_in, ws_size); grid = -1; return; }
        int dev = 0, cus = 0, per_cu = 0;
        hipGetDevice(&dev); hipDeviceGetAttribute(&cus, hipDeviceAttributeMultiprocessorCount, dev);
        hipFuncSetAttribute((const void*)fwd_kernel, hipFuncAttributeMaxDynamicSharedMemorySize, LDS_BYTES);
        hipOccupancyMaxActiveBlocksPerMultiprocessor(&per_cu, (const void*)fwd_kernel, NTHR, LDS_BYTES);
        (void)hipGetLastError();
        if (per_cu < 1) { fprintf(stderr, "kernel_launch: occupancy query says %d blocks/CU\n", per_cu); per_cu = 1; }
        grid = cus;
    }
    if (grid < 0) return;
    if (hipMemsetAsync(d_ws, 0, CTL_ZERO_BYTES, stream) != hipSuccess) { fprintf(stderr, "memset failed\n"); return; }
    Args a{};
    for (int i = 0; i < 21; ++i) a.in[i] = d_in[i];
    a.out = (float*)d_out; a.ws = (unsigned char*)d_ws;
#if N_LAUNCH_SPLIT
    for (int p = 0; p < N_PHASES; ++p) { a.ph_lo = p; a.ph_hi = p + 1; void* kargs[] = {&a};
        hipError_t e = hipLaunchCooperativeKernel((const void*)fwd_kernel, dim3(grid), dim3(NTHR), kargs, LDS_BYTES, stream);
        if (e != hipSuccess) { fprintf(stderr, "launch %d failed: %s\n", p, hipGetErrorString(e)); break; } }
#else
    a.ph_lo = 0; a.ph_hi = N_PHASES; void* kargs[] = {&a};
    hipError_t e = hipLaunchCooperativeKernel((const void*)fwd_kernel, dim3(grid), dim3(NTHR), kargs, LDS_BYTES, stream);
    if (e != hipSuccess) fprintf(stderr, "cooperative launch failed: %s (grid %d)\n", hipGetErrorString(e), grid);
#endif
}
```
